# Optimizing an MI355X kernel written in HIP

```python
import math
import jax, jax.numpy as jnp
from jax import lax
import numpy as np

D_MODEL = 1024
BATCH = 8
SEQ = 2048
DEPTH = 4

N_MIXERS = 2
N_GLA = (DEPTH + 1) // 2
N_MLA = DEPTH // 2
EPS = 1e-6

D_FF = 2816

GLA_HEADS = 4
GLA_DK_TOT = D_MODEL // 2
GLA_DV_TOT = D_MODEL
GLA_DK = GLA_DK_TOT // GLA_HEADS
GLA_DV = GLA_DV_TOT // GLA_HEADS
GLA_GATE_RANK = 16
GLA_TAU = 16.0
GLA_CHUNK = 64
GLA_IN = 2 * GLA_DK_TOT + 2 * GLA_DV_TOT + 2 * GLA_GATE_RANK

MLA_HEADS = 8
MLA_NOPE = 128
MLA_ROPE = 64
MLA_V = 128
MLA_Q_RANK = 768
MLA_KV_RANK = 256
MLA_QK = MLA_NOPE + MLA_ROPE
MLA_IN = MLA_Q_RANK + MLA_KV_RANK + MLA_ROPE
ROPE_THETA = 10000.0
Q_BLOCK = 128
MAX_POS_OFFSET = 4096

kernel_name = "hybrid_gla_mla_macaron_encoder"


def rms_norm(x, g):
    xf = x.astype(jnp.float32)
    y = xf * lax.rsqrt(jnp.mean(xf * xf, axis=-1, keepdims=True) + EPS)
    return (y * g.astype(jnp.float32)).astype(x.dtype)


def swiglu(h, w_gu, w_down):
    gate, up = jnp.split(h @ w_gu, [D_FF], axis=-1)
    return (jax.nn.silu(gate) * up) @ w_down


def gla_direction(q, k, v, log_a, include_diag):
    bsz, nh, seq, dk = q.shape
    dv = v.shape[-1]
    n = seq // GLA_CHUNK

    def to_chunks(t):
        return jnp.moveaxis(t.reshape(bsz, nh, n, GLA_CHUNK, t.shape[-1]), 2, 0)

    qc, kc, vc = to_chunks(q), to_chunks(k), to_chunks(v)
    bc = jnp.cumsum(to_chunks(log_a), axis=-2)
    mask = jnp.tril(jnp.ones((GLA_CHUNK, GLA_CHUNK), dtype=bool), k=0 if include_diag else -1)

    def step(state, inp):
        q_, k_, v_, b_ = inp
        diff = b_[:, :, :, None, :] - b_[:, :, None, :, :]
        decay = jnp.exp(jnp.where(mask[:, :, None], diff, -jnp.inf))
        scores = jnp.einsum('bhtd,bhsd,bhtsd->bhts', q_, k_, decay)
        out = (jnp.einsum('bhts,bhsv->bhtv', scores, v_)
               + jnp.einsum('bhtd,bhdv->bhtv', q_ * jnp.exp(b_), state))
        b_end = b_[:, :, -1:, :]
        state = (state * jnp.exp(b_end)[:, :, 0, :, None]
                 + jnp.einsum('bhsd,bhsv->bhdv', k_ * jnp.exp(b_end - b_), v_))
        return state, out

    state0 = jnp.zeros((bsz, nh, dk, dv), jnp.float32)
    _, out = lax.scan(step, state0, (qc, kc, vc, bc))
    return jnp.moveaxis(out, 0, 2).reshape(bsz, nh, seq, dv)


def gla_mixer(h, w_in, w_gate2, b_gate, head_norm, w_out):
    bsz, seq, _ = h.shape
    splits = [GLA_DK_TOT, 2 * GLA_DK_TOT, 2 * GLA_DK_TOT + GLA_DV_TOT,
              2 * GLA_DK_TOT + 2 * GLA_DV_TOT, 2 * GLA_DK_TOT + 2 * GLA_DV_TOT + GLA_GATE_RANK]
    q, k, v, r, g_fw, g_bw = jnp.split(h @ w_in, splits, axis=-1)

    def heads(t, d):
        return t.reshape(bsz, seq, GLA_HEADS, d).transpose(0, 2, 1, 3).astype(jnp.float32)

    q = heads(q, GLA_DK) * (GLA_DK ** -0.5)
    k = heads(k, GLA_DK)
    v = heads(v, GLA_DV)
    log_fw = heads(jax.nn.log_sigmoid(g_fw @ w_gate2[0] + b_gate[0]), GLA_DK) / GLA_TAU
    log_bw = heads(jax.nn.log_sigmoid(g_bw @ w_gate2[1] + b_gate[1]), GLA_DK) / GLA_TAU

    flip = lambda t: t[:, :, ::-1, :]
    o_fw = gla_direction(q, k, v, log_fw, True)
    o_bw = flip(gla_direction(flip(q), flip(k), flip(v), flip(log_bw), False))
    o = (o_fw + o_bw).transpose(0, 2, 1, 3)
    o = rms_norm(o, head_norm).astype(h.dtype)
    o = o * jax.nn.silu(r).reshape(bsz, seq, GLA_HEADS, GLA_DV)
    return o.reshape(bsz, seq, GLA_DV_TOT) @ w_out


def apply_rope(x, cos, sin):
    c = cos[:, :, None, :].astype(x.dtype)
    s = sin[:, :, None, :].astype(x.dtype)
    x1, x2 = jnp.split(x, 2, axis=-1)
    return jnp.concatenate([x1 * c - x2 * s, x2 * c + x1 * s], axis=-1)


def mla_mixer(h, cos, sin, w_in, q_norm, kv_norm, w_uq, w_ukv, w_out):
    bsz, seq, _ = h.shape
    c_q, c_kv, k_pe = jnp.split(h @ w_in, [MLA_Q_RANK, MLA_Q_RANK + MLA_KV_RANK], axis=-1)
    q = (rms_norm(c_q, q_norm) @ w_uq).reshape(bsz, seq, MLA_HEADS, MLA_QK)
    q_nope, q_pe = jnp.split(q, [MLA_NOPE], axis=-1)
    kv = (rms_norm(c_kv, kv_norm) @ w_ukv).reshape(bsz, seq, MLA_HEADS, MLA_NOPE + MLA_V)
    k_nope, v = jnp.split(kv, [MLA_NOPE], axis=-1)
    q_pe = apply_rope(q_pe, cos, sin)
    k_pe = apply_rope(k_pe[:, :, None, :], cos, sin)
    q_full = jnp.concatenate([q_nope, q_pe], axis=-1).transpose(0, 2, 1, 3)
    k_full = jnp.concatenate(
        [k_nope, jnp.broadcast_to(k_pe, (bsz, seq, MLA_HEADS, MLA_ROPE))], axis=-1
    ).transpose(0, 2, 1, 3)
    v = v.transpose(0, 2, 1, 3)
    scale = MLA_QK ** -0.5
    n_blk = seq // Q_BLOCK
    q_blocks = jnp.moveaxis(q_full.reshape(bsz, MLA_HEADS, n_blk, Q_BLOCK, MLA_QK), 2, 0)

    def attend(qb):
        s = jnp.einsum('bhqd,bhkd->bhqk', qb, k_full).astype(jnp.float32) * scale
        p = jax.nn.softmax(s, axis=-1).astype(v.dtype)
        return jnp.einsum('bhqk,bhkv->bhqv', p, v)

    out = lax.map(attend, q_blocks)
    out = jnp.moveaxis(out, 0, 2).reshape(bsz, MLA_HEADS, seq, MLA_V)
    out = out.transpose(0, 2, 1, 3).reshape(bsz, seq, MLA_HEADS * MLA_V)
    return out @ w_out


def setup_inputs(seed: int = 0) -> dict:
    key = jax.random.key(seed)
    ks = jax.random.split(key, 24)

    def dense(k, shape, fan_in):
        return jax.random.normal(k, shape, jnp.float32) * (fan_in ** -0.5)

    def gain(k, shape):
        return 1.0 + 0.02 * jax.random.normal(k, shape, jnp.float32)

    x = jax.random.normal(ks[0], (BATCH, SEQ, D_MODEL), jnp.float32)
    positions = (jnp.arange(SEQ, dtype=jnp.int32)[None, :]
                 + jax.random.randint(ks[1], (BATCH, 1), 0, MAX_POS_OFFSET, dtype=jnp.int32))
    return {
        "x": x,
        "positions": positions,
        "ffn_norm": gain(ks[2], (DEPTH, 2, D_MODEL)),
        "ffn_w_gu": dense(ks[3], (DEPTH, 2, D_MODEL, 2 * D_FF), D_MODEL),
        "ffn_w_down": dense(ks[4], (DEPTH, 2, D_FF, D_MODEL), D_FF),
        "mix_norm": gain(ks[5], (DEPTH, D_MODEL)),
        "gla_w_in": dense(ks[6], (N_GLA, D_MODEL, GLA_IN), D_MODEL),
        "gla_w_gate2": dense(ks[7], (N_GLA, 2, GLA_GATE_RANK, GLA_DK_TOT), GLA_GATE_RANK),
        "gla_b_gate": 0.1 * jax.random.normal(ks[8], (N_GLA, 2, GLA_DK_TOT), jnp.float32),
        "gla_head_norm": gain(ks[9], (N_GLA, GLA_DV)),
        "gla_w_out": dense(ks[10], (N_GLA, GLA_DV_TOT, D_MODEL), GLA_DV_TOT),
        "mla_w_in": dense(ks[11], (N_MLA, D_MODEL, MLA_IN), D_MODEL),
        "mla_q_norm": gain(ks[12], (N_MLA, MLA_Q_RANK)),
        "mla_kv_norm": gain(ks[13], (N_MLA, MLA_KV_RANK)),
        "mla_w_uq": dense(ks[14], (N_MLA, MLA_Q_RANK, MLA_HEADS * MLA_QK), MLA_Q_RANK),
        "mla_w_ukv": dense(ks[15], (N_MLA, MLA_KV_RANK, MLA_HEADS * (MLA_NOPE + MLA_V)), MLA_KV_RANK),
        "mla_w_out": dense(ks[16], (N_MLA, MLA_HEADS * MLA_V, D_MODEL), MLA_HEADS * MLA_V),
        "final_norm": gain(ks[17], (D_MODEL,)),
    }


def reference(x, positions, ffn_norm, ffn_w_gu, ffn_w_down, mix_norm,
              gla_w_in, gla_w_gate2, gla_b_gate, gla_head_norm, gla_w_out,
              mla_w_in, mla_q_norm, mla_kv_norm, mla_w_uq, mla_w_ukv, mla_w_out,
              final_norm):
    inv_freq = 1.0 / (ROPE_THETA ** (jnp.arange(0, MLA_ROPE, 2, dtype=jnp.float32) / MLA_ROPE))
    ang = positions.astype(jnp.float32)[..., None] * inv_freq
    cos, sin = jnp.cos(ang), jnp.sin(ang)

    for i in range(DEPTH):
        x = x + 0.5 * swiglu(rms_norm(x, ffn_norm[i, 0]), ffn_w_gu[i, 0], ffn_w_down[i, 0])
        h = rms_norm(x, mix_norm[i])
        j = i // N_MIXERS
        if i % N_MIXERS == 0:
            x = x + gla_mixer(h, gla_w_in[j], gla_w_gate2[j], gla_b_gate[j],
                              gla_head_norm[j], gla_w_out[j])
        else:
            x = x + mla_mixer(h, cos, sin, mla_w_in[j], mla_q_norm[j], mla_kv_norm[j],
                              mla_w_uq[j], mla_w_ukv[j], mla_w_out[j])
        x = x + 0.5 * swiglu(rms_norm(x, ffn_norm[i, 1]), ffn_w_gu[i, 1], ffn_w_down[i, 1])
    return rms_norm(x, final_norm)
```

```cpp
#include <hip/hip_runtime.h>
#include <hip/hip_cooperative_groups.h>
#include <cstdio>
#include <cmath>
namespace cg = cooperative_groups;
__device__ __forceinline__ int otid() { int t = threadIdx.x; asm volatile("" : "+v"(t)); return t; }
__device__ __forceinline__ int obid() { int b = blockIdx.x; asm volatile("" : "+s"(b)); return b; }
__device__ __forceinline__ int ogrid() { int g = gridDim.x; asm volatile("" : "+s"(g)); return g; }
namespace pg8 {
#define PG8_LAS __attribute__((address_space(3)))
typedef unsigned short bf16_t;
typedef short bf16x8 __attribute__((ext_vector_type(8)));
typedef float f32x4 __attribute__((ext_vector_type(4)));
typedef unsigned u32x4 __attribute__((ext_vector_type(4)));
constexpr int BM = 256, BK = 64, HALF = 128, HTB = HALF * BK * 2  , STAGE_BYTES = 8 * HTB, NXCD = 8, WGM = 8;

__host__ __device__ __forceinline__ int lds_byte(int r, int c) { const int st = (r >> 4) * 2 + (c >> 5), rr = r & 15, cc = c & 31, ob = rr * 64 + cc * 2; return st * 1024 + (ob ^ (((ob >> 9) & 1) << 5)); }
__host__ __device__ __forceinline__ void stage_rc(int b, int& R, int& C) { const int st = b / 1024, sb = b % 1024, swz = sb ^ (((sb >> 9) & 1) << 5); R = (st >> 1) * 16 + swz / 64; C = (st & 1) * 32 + (swz % 64) / 2; }
__host__ __device__ __forceinline__ int perm32(int rho) { const int n = rho >> 4, i = rho & 15; return 8 * (i >> 2) + 4 * n + (i & 3); }

struct Unit { int pm, pn; };
struct Gemm { const bf16_t* A; const bf16_t* Bt; int M, N, K; };

struct StaticOrder {
    int nM, nN, nwg, G, c;
    __host__ __device__ void init(int M, int N, int G_, int c_) { nM = M / BM; nN = N / BM; nwg = nM * nN; G = G_; c = c_; }
    __host__ __device__ bool next(int i, Unit& u) const {
        const long L = (long)i * G + c; if (L >= nwg) return false;
        int wgid = (int)L; { const int q = nwg / NXCD, r = nwg % NXCD, xcd = wgid % NXCD, off = wgid / NXCD; wgid = (xcd < r ? xcd * (q + 1) : r * (q + 1) + (xcd - r) * q) + off; }
        const int nig = WGM * nN, gid = wgid / nig, fm = gid * WGM, gsz = (nM - fm) < WGM ? (nM - fm) : WGM;
        u.pm = fm + ((wgid % nig) % gsz); u.pn = (wgid % nig) / gsz; return true;
    }
    __device__ __forceinline__ void a_ready(const Unit&) const {}
    __device__ __forceinline__ void done(const Unit&) const {}
};
template <class Epi, class Sched, bool STAMP = false>
__device__ __forceinline__ void gemm_phase(PG8_LAS unsigned char* lds, const Gemm g, const Sched& S, const Epi& E, unsigned long long* stamps) {
    const int tid = otid(), wid = __builtin_amdgcn_readfirstlane(tid >> 6), lane = tid & 63, wr = wid >> 2, wc = wid & 3, fr = lane & 15, fq = lane >> 4;
    const int K = g.K, nt = K / BK;
    int ts_lo = 0, ts_hi = 0, nts = 0; const unsigned long long rt_entry = STAMP ? (unsigned long long)wall_clock64() : 0ull;
#define PG8_STAMP() do { if (STAMP && wid == 0 && nts < 64) { const unsigned long long _c = (unsigned long long)clock64(); \
        ts_lo = (lane == nts) ? (int)(unsigned)_c : ts_lo; ts_hi = (lane == nts) ? (int)(unsigned)(_c >> 32) : ts_hi; ++nts; } } while (0)
    PG8_STAMP();
    unsigned voffA[2], voffB[2];
#pragma unroll
    for (int i = 0; i < 2; ++i) { int R, C; stage_rc(tid * 16 + i * 8192, R, C); const int Rb = Epi::PERM ? ((R & ~31) + perm32(R & 31)) : R;
        voffA[i] = (unsigned)(R * K + C) * 2u; voffB[i] = (unsigned)(Rb * K + C) * 2u; }
    const size_t kstep = (size_t)(BK * 2);
    const size_t hstep = (size_t)HALF * K * 2;
    const size_t tstep = 2 * hstep;
    const unsigned ldsw = (unsigned)wid * 1024u;
    const int aoff = lds_byte(wr * 64 + fr, fq * 8), boff = lds_byte(wc * 32 + fr, fq * 8);
#define PG8_SA(b, h) (((b) * 2 + (h)) * HTB)
#define PG8_SB(b, h) ((4 + (b) * 2 + (h)) * HTB)
#define PG8_STAGE(bufoff, gbase, voff) do { _Pragma("unroll") for (int _i = 0; _i < 2; ++_i) \
        __builtin_amdgcn_global_load_lds((const unsigned*)((const char*)(gbase) + (voff)[_i]), (PG8_LAS unsigned*)(lds + (bufoff) + ldsw + _i * 8192), 16, 0, 0); } while (0)
#define PG8_LDA(dst, b, h) do { _Pragma("unroll") for (int m = 0; m < 4; ++m) _Pragma("unroll") for (int k = 0; k < 2; ++k) dst[m][k] = *(const PG8_LAS bf16x8*)(lds + PG8_SA(b, h) + aoff + m * 2048 + k * 1024); } while (0)
#define PG8_LDB(dst, b, h) do { _Pragma("unroll") for (int n = 0; n < 2; ++n) _Pragma("unroll") for (int k = 0; k < 2; ++k) dst[n][k] = *(const PG8_LAS bf16x8*)(lds + PG8_SB(b, h) + boff + n * 2048 + k * 1024); } while (0)
#define PG8_MMA(ai, bj, At, Bt) do { __builtin_amdgcn_s_setprio(1); _Pragma("unroll") for (int m = 0; m < 4; ++m) _Pragma("unroll") for (int n = 0; n < 2; ++n) _Pragma("unroll") for (int k = 0; k < 2; ++k) \
        acc[ai][bj][m][n] = __builtin_amdgcn_mfma_f32_16x16x32_bf16(Bt[n][k], At[m][k], acc[ai][bj][m][n], 0, 0, 0); __builtin_amdgcn_s_setprio(0); } while (0)
#define PG8_WAIT_V(n) asm volatile("s_waitcnt vmcnt(" #n ")" ::: "memory")
#define PG8_WAIT_L(n) asm volatile("s_waitcnt lgkmcnt(" #n ")" ::: "memory")
#define PG8_BAR __builtin_amdgcn_s_barrier()
#define PG8_SCHED __builtin_amdgcn_sched_barrier(0)
    Unit cur, nxt; int ui = 0;
    if (!S.next(0, cur)) return;
    f32x4 acc[2][2][4][2];
#pragma unroll
    for (int a = 0; a < 2; ++a)
#pragma unroll
        for (int b = 0; b < 2; ++b)
#pragma unroll
            for (int m = 0; m < 4; ++m)
#pragma unroll
                for (int n = 0; n < 2; ++n) acc[a][b][m][n] = (f32x4){0.f, 0.f, 0.f, 0.f};
    bf16x8 At[4][2], B0[2][2], B1[2][2];
    const char* cA = (const char*)g.A + (size_t)cur.pm * tstep; const char* cB = (const char*)g.Bt + (size_t)cur.pn * tstep;
    S.a_ready(cur);
    PG8_STAGE(PG8_SB(0, 0), cB, voffB); PG8_STAGE(PG8_SA(0, 0), cA, voffA); PG8_STAGE(PG8_SB(0, 1), cB + hstep, voffB); PG8_STAGE(PG8_SA(0, 1), cA + hstep, voffA);
    if (wr == 1) PG8_BAR;
    PG8_WAIT_V(4); PG8_BAR;
    PG8_STAGE(PG8_SB(1, 0), cB + kstep, voffB); PG8_STAGE(PG8_SA(1, 0), cA + kstep, voffA); PG8_STAGE(PG8_SB(1, 1), cB + hstep + kstep, voffB);
    PG8_WAIT_V(6); PG8_BAR;
    PG8_STAMP();
    for (;;) {
        const bool has_next = S.next(ui + 1, nxt);
        const char* nA = has_next ? (const char*)g.A + (size_t)nxt.pm * tstep : cA; const char* nB = has_next ? (const char*)g.Bt + (size_t)nxt.pn * tstep : cB;
        for (int t = 0; t < nt; t += 2) {
            const bool last = (t == nt - 2);
            const char* a1 = cA + (size_t)(t + 1) * kstep;
            const char* a2 = last ? nA : cA + (size_t)(t + 2) * kstep; const char* b2 = last ? nB : cB + (size_t)(t + 2) * kstep;
            const char* a3 = a2 + kstep; const char* b3 = b2 + kstep;
            if (last && has_next) S.a_ready(nxt);
            PG8_LDB(B0, 0, 0); PG8_SCHED; PG8_LDA(At, 0, 0); PG8_STAGE(PG8_SA(1, 1), a1 + hstep, voffA);
            PG8_WAIT_L(8); PG8_BAR; PG8_WAIT_L(0); PG8_MMA(0, 0, At, B0); PG8_BAR; PG8_SCHED;
            PG8_LDB(B1, 0, 1); PG8_STAGE(PG8_SB(0, 0), b2, voffB);
            PG8_BAR; PG8_WAIT_L(0); PG8_MMA(0, 1, At, B1); PG8_BAR;
            PG8_LDA(At, 0, 1); PG8_STAGE(PG8_SA(0, 0), a2, voffA);
            PG8_BAR; PG8_WAIT_L(0); PG8_MMA(1, 0, At, B0); PG8_BAR; PG8_SCHED;
            PG8_STAGE(PG8_SB(0, 1), b2 + hstep, voffB);
            PG8_WAIT_V(6); PG8_BAR; PG8_MMA(1, 1, At, B1); PG8_BAR;
            PG8_LDB(B0, 1, 0); PG8_SCHED; PG8_LDA(At, 1, 0); PG8_STAGE(PG8_SA(0, 1), a2 + hstep, voffA);
            PG8_WAIT_L(8); PG8_BAR; PG8_WAIT_L(0); PG8_MMA(0, 0, At, B0); PG8_BAR; PG8_SCHED;
            PG8_LDB(B1, 1, 1); PG8_STAGE(PG8_SB(1, 0), b3, voffB);
            PG8_BAR; PG8_WAIT_L(0); PG8_MMA(0, 1, At, B1); PG8_BAR;
            PG8_LDA(At, 1, 1); PG8_STAGE(PG8_SA(1, 0), a3, voffA);
            PG8_BAR; PG8_WAIT_L(0); PG8_MMA(1, 0, At, B0); PG8_BAR; PG8_SCHED;
            PG8_STAGE(PG8_SB(1, 1), b3 + hstep, voffB);
            PG8_WAIT_V(6); PG8_BAR; PG8_MMA(1, 1, At, B1); PG8_BAR;
        }
        PG8_STAMP();
        if constexpr (!Epi::AFTER_DRAIN) { E(acc, cur, wr, wc, fr, fq); S.done(cur); }
        PG8_STAMP();
        if (!has_next) break;
#pragma unroll
        for (int a = 0; a < 2; ++a)
#pragma unroll
            for (int b = 0; b < 2; ++b)
#pragma unroll
                for (int m = 0; m < 4; ++m)
#pragma unroll
                    for (int n = 0; n < 2; ++n) acc[a][b][m][n] = (f32x4){0.f, 0.f, 0.f, 0.f};
        cur = nxt; cA = nA; cB = nB; ++ui;
    }
    PG8_WAIT_V(0);
    if (wr == 0) PG8_BAR;
    PG8_BAR;
    if constexpr (Epi::AFTER_DRAIN) { E.fused(acc, cur, wr, wc, fr, fq, lds, wid, lane); S.done(cur); }
    PG8_STAMP();
    if (STAMP && wid == 0) { stamps[lane] = lane < nts ? (((unsigned long long)(unsigned)ts_hi << 32) | (unsigned)ts_lo) : 0ull;
        if (lane == 62) stamps[62] = rt_entry; if (lane == 63) stamps[63] = (unsigned long long)wall_clock64(); }
#undef PG8_STAMP
#undef PG8_SA
#undef PG8_SB
#undef PG8_STAGE
#undef PG8_LDA
#undef PG8_LDB
#undef PG8_MMA
#undef PG8_WAIT_V
#undef PG8_WAIT_L
#undef PG8_BAR
#undef PG8_SCHED
}
}
using pg8::bf16_t; using pg8::bf16x8; using pg8::f32x4; using pg8::u32x4; using pg8::Unit;
typedef float f32x16 __attribute__((ext_vector_type(16)));
typedef float f32x2 __attribute__((ext_vector_type(2)));
typedef unsigned u32x2 __attribute__((ext_vector_type(2)));
typedef short s16x4 __attribute__((ext_vector_type(4)));
typedef __bf16 bf16x2v __attribute__((ext_vector_type(2)));
#define DI __device__ __forceinline__
#define LAS __attribute__((address_space(3)))

constexpr int MT = 16384, DM = 1024, DFF = 2816, SEQ = 2048, NBATCH = 8;
constexpr int GLA_N = 3104, MLA_N = 1088;
constexpr float EPS = 1e-6f;
constexpr int LDS_BYTES = 147456;

constexpr size_t SZ_WGU = (size_t)5632 * 1024 * 2, SZ_WD = (size_t)1024 * 2816 * 2;
constexpr size_t WS_WGU = 0;
constexpr size_t WS_WD = WS_WGU + 8 * SZ_WGU;
constexpr size_t WS_GWIN = WS_WD + 8 * SZ_WD;
constexpr size_t WS_GWG = WS_GWIN + 2 * (size_t)3072 * 1024 * 2;
constexpr size_t WS_GWOUT = WS_GWG + 2 * (size_t)32 * 1024 * 2;
constexpr size_t WS_MWIN = WS_GWOUT + 2 * (size_t)1024 * 1024 * 2;
constexpr size_t WS_MWKPE = WS_MWIN + 2 * (size_t)1024 * 1024 * 2;
constexpr size_t WS_MWUQ = WS_MWKPE + 2 * (size_t)64 * 1024 * 2;
constexpr size_t WS_MWUKV = WS_MWUQ + 2 * (size_t)1536 * 768 * 2;
constexpr size_t WS_MWOUT = WS_MWUKV + 2 * (size_t)2048 * 256 * 2;
constexpr size_t WS_XRES = WS_MWOUT + 2 * (size_t)1024 * 1024 * 2;
constexpr size_t WS_XB = WS_XRES + (size_t)MT * 1024 * 4;
constexpr size_t WS_ACT = WS_XB + (size_t)MT * 1024 * 2;
constexpr size_t WS_SSQ = WS_ACT + (size_t)MT * 2816 * 2;
constexpr size_t WS_SSQQ = WS_SSQ + (size_t)13 * MT * 16 * 4;
constexpr size_t WS_COS = WS_SSQQ + (size_t)2 * MT * 16 * 4;
constexpr size_t WS_SIN = WS_COS + (size_t)MT * 32 * 4;
constexpr size_t WS_MIX = WS_SIN + (size_t)MT * 32 * 4;
constexpr size_t WS_G = WS_MIX;
constexpr size_t WS_GG = WS_G + (size_t)MT * 3072 * 2;
constexpr size_t WS_OFW = WS_GG + (size_t)MT * 32 * 4;
constexpr size_t WS_OBW = WS_OFW + (size_t)MT * 1024 * 2;
constexpr size_t WS_ON = WS_OBW + (size_t)MT * 1024 * 2;
constexpr size_t WS_GLA_END = WS_ON + (size_t)MT * 1024 * 2;
constexpr size_t WS_CQ = WS_MIX;
constexpr size_t WS_CKV = WS_CQ + (size_t)MT * 768 * 2;
constexpr size_t WS_Q = WS_CKV + (size_t)MT * 256 * 2;
constexpr size_t WS_KB = WS_Q + (size_t)MT * 8 * 192 * 2;
constexpr size_t WS_VB = WS_KB + (size_t)MT * 8 * 192 * 2;
constexpr size_t WS_O = WS_VB + (size_t)MT * 8 * 128 * 2;
constexpr size_t WS_MLA_END = WS_O + (size_t)MT * 1024 * 2;
constexpr size_t WS_END = WS_GLA_END > WS_MLA_END ? WS_GLA_END : WS_MLA_END;

struct Params {
    const float* in[18];
    float* out;
    unsigned char* ws;
    float inv_freq[32];
    int ph_lo, ph_hi;
};
enum { I_X = 0, I_POS, I_FFN_NORM, I_FFN_WGU, I_FFN_WD, I_MIX_NORM, I_GLA_WIN, I_GLA_WG2, I_GLA_BG, I_GLA_HN, I_GLA_WOUT,
       I_MLA_WIN, I_MLA_QN, I_MLA_KVN, I_MLA_WUQ, I_MLA_WUKV, I_MLA_WOUT, I_FINAL_NORM };

DI unsigned pk2(float a, float b) { f32x2 v = {a, b}; bf16x2v r = __builtin_convertvector(v, bf16x2v); return __builtin_bit_cast(unsigned, r); }
DI float bf2f(bf16_t v) { return __uint_as_float(((unsigned)v) << 16); }
DI float bflo(unsigned w) { return __uint_as_float(w << 16); }
DI float bfhi(unsigned w) { return __uint_as_float(w & 0xffff0000u); }
DI float silu_f(float g) { return g * __builtin_amdgcn_rcpf(1.0f + __expf(-g)); }
DI u32x4 pack8(const f32x4& a, const f32x4& b) { u32x4 w; w.x = pk2(a[0], a[1]); w.y = pk2(a[2], a[3]); w.z = pk2(b[0], b[1]); w.w = pk2(b[2], b[3]); return w; }
DI unsigned char* lws(const Params& p) { unsigned char* w = p.ws; asm volatile("" : "+s"(w)); return w; }
DI float* lout(const Params& p) { float* w = p.out; asm volatile("" : "+s"(w)); return w; }
DI const float* IN(const Params& p, int i) { const float* w = p.in[i]; asm volatile("" : "+s"(w)); return w; }
DI float sum16(const float* s) { const f32x4 a = *(const f32x4*)s, b = *(const f32x4*)(s + 4), c = *(const f32x4*)(s + 8), d = *(const f32x4*)(s + 12);
    return ((a[0] + a[1]) + (a[2] + a[3])) + ((b[0] + b[1]) + (b[2] + b[3])) + ((c[0] + c[1]) + (c[2] + c[3])) + ((d[0] + d[1]) + (d[2] + d[3])); }
DI float row_rstd(const float* ssqp, int row) { return rsqrtf(sum16(ssqp + (size_t)row * 16) * (1.0f / 1024.0f) + EPS); }
struct CvtJob { const float* src; const float* gain; bf16_t* dst; int K, ldn, N, mode, coloff; };
DI int cvt_map(int mode, int coloff, int n) {
    if (mode == 1) { const int pn = n >> 8, bj = (n >> 7) & 1, i = n & 127; return bj * DFF + pn * 128 + i; }
    if (mode == 2) { if (n < 1024) return (n >> 7) * 192 + (n & 127); const int cr = n - 1024, head = cr >> 6, idx = cr & 63; return head * 192 + 128 + (idx & 1) * 32 + (idx >> 1); }
    return coloff + n;
}
DI CvtJob get_job(const Params& p, int idx) {
    CvtJob j; j.gain = nullptr; j.mode = 0; j.coloff = 0;
    unsigned char* ws = lws(p);
    if (idx < 16) { const int t = idx >> 1;
        if ((idx & 1) == 0) { j.src = IN(p, I_FFN_WGU) + (size_t)t * 1024 * 5632; j.gain = IN(p, I_FFN_NORM) + t * 1024; j.dst = (bf16_t*)(ws + WS_WGU + t * SZ_WGU); j.K = 1024; j.ldn = 5632; j.N = 5632; j.mode = 1; }
        else { j.src = IN(p, I_FFN_WD) + (size_t)t * 2816 * 1024; j.dst = (bf16_t*)(ws + WS_WD + t * SZ_WD); j.K = 2816; j.ldn = 1024; j.N = 1024; }
    } else if (idx < 22) { const int g = (idx - 16) / 3, w = (idx - 16) % 3;
        if (w == 0) { j.src = IN(p, I_GLA_WIN) + (size_t)g * 1024 * GLA_N; j.gain = IN(p, I_MIX_NORM) + (2 * g) * 1024; j.dst = (bf16_t*)(ws + WS_GWIN + (size_t)g * 3072 * 1024 * 2); j.K = 1024; j.ldn = GLA_N; j.N = 3072; }
        else if (w == 1) { j.src = IN(p, I_GLA_WIN) + (size_t)g * 1024 * GLA_N; j.gain = IN(p, I_MIX_NORM) + (2 * g) * 1024; j.dst = (bf16_t*)(ws + WS_GWG + (size_t)g * 32 * 1024 * 2); j.K = 1024; j.ldn = GLA_N; j.N = 32; j.coloff = 3072; }
        else { j.src = IN(p, I_GLA_WOUT) + (size_t)g * 1024 * 1024; j.dst = (bf16_t*)(ws + WS_GWOUT + (size_t)g * 1024 * 1024 * 2); j.K = 1024; j.ldn = 1024; j.N = 1024; }
    } else { const int g = (idx - 22) / 5, w = (idx - 22) % 5;
        if (w == 0) { j.src = IN(p, I_MLA_WIN) + (size_t)g * 1024 * MLA_N; j.gain = IN(p, I_MIX_NORM) + (2 * g + 1) * 1024; j.dst = (bf16_t*)(ws + WS_MWIN + (size_t)g * 1024 * 1024 * 2); j.K = 1024; j.ldn = MLA_N; j.N = 1024; }
        else if (w == 1) { j.src = IN(p, I_MLA_WIN) + (size_t)g * 1024 * MLA_N; j.gain = IN(p, I_MIX_NORM) + (2 * g + 1) * 1024; j.dst = (bf16_t*)(ws + WS_MWKPE + (size_t)g * 64 * 1024 * 2); j.K = 1024; j.ldn = MLA_N; j.N = 64; j.coloff = 1024; }
        else if (w == 2) { j.src = IN(p, I_MLA_WUQ) + (size_t)g * 768 * 1536; j.gain = IN(p, I_MLA_QN) + g * 768; j.dst = (bf16_t*)(ws + WS_MWUQ + (size_t)g * 1536 * 768 * 2); j.K = 768; j.ldn = 1536; j.N = 1536; j.mode = 2; }
        else if (w == 3) { j.src = IN(p, I_MLA_WUKV) + (size_t)g * 256 * 2048; j.gain = IN(p, I_MLA_KVN) + g * 256; j.dst = (bf16_t*)(ws + WS_MWUKV + (size_t)g * 2048 * 256 * 2); j.K = 256; j.ldn = 2048; j.N = 2048; }
        else { j.src = IN(p, I_MLA_WOUT) + (size_t)g * 1024 * 1024; j.dst = (bf16_t*)(ws + WS_MWOUT + (size_t)g * 1024 * 1024 * 2); j.K = 1024; j.ldn = 1024; j.N = 1024; }
    }
    return j;
}
DI void cvt_weights(const Params& p) {
    const int tid = otid(), nn = tid & 31, kk = tid >> 5;
    for (int ji = 0; ji < 32; ++ji) {
        const CvtJob j = get_job(p, ji);
        const int ntk = j.K >> 7, ntn = j.N >> 5, nt = ntk * ntn;
        for (int t = obid(); t < nt; t += ogrid()) {
            const int tn = t % ntn, tk = t / ntn;
            const int n = tn * 32 + nn, k0 = tk * 128 + kk * 8;
            const int sc = cvt_map(j.mode, j.coloff, n);
            const float* sp = j.src + (size_t)k0 * j.ldn + sc;
            float v[8];
#pragma unroll
            for (int e = 0; e < 8; ++e) v[e] = sp[(size_t)e * j.ldn];
            if (j.gain) {
#pragma unroll
                for (int e = 0; e < 8; ++e) v[e] *= j.gain[k0 + e];
            }
            u32x4 w; w.x = pk2(v[0], v[1]); w.y = pk2(v[2], v[3]); w.z = pk2(v[4], v[5]); w.w = pk2(v[6], v[7]);
            *(u32x4*)(j.dst + (size_t)n * j.K + k0) = w;
        }
    }
}
DI void prep_phase(const Params& p) {
    const int tid = otid(), lane = tid & 63, wv = obid() * 8 + (tid >> 6), nwv = ogrid() * 8;
    unsigned char* ws = lws(p);
    { const float* x = IN(p, I_X); float* xres = (float*)(ws + WS_XRES); bf16_t* xb = (bf16_t*)(ws + WS_XB); float* ssq0 = (float*)(ws + WS_SSQ);
      for (int row = wv; row < MT; row += nwv) {
          const f32x4* s = (const f32x4*)(x + (size_t)row * 1024); float ss = 0.f;
#pragma unroll
          for (int i = 0; i < 4; ++i) { const f32x4 v = s[lane + 64 * i]; ss += v[0] * v[0] + v[1] * v[1] + v[2] * v[2] + v[3] * v[3];
              ((f32x4*)(xres + (size_t)row * 1024))[lane + 64 * i] = v; u32x2 w; w.x = pk2(v[0], v[1]); w.y = pk2(v[2], v[3]);
              ((u32x2*)(xb + (size_t)row * 1024))[lane + 64 * i] = w; }
#pragma unroll
          for (int o = 32; o >= 1; o >>= 1) ss += __shfl_xor(ss, o);
          if (lane < 16) ssq0[(size_t)row * 16 + lane] = lane == 0 ? ss : 0.f;
      } }
    { const int* pos = (const int*)IN(p, I_POS); float* ct = (float*)(ws + WS_COS); float* st = (float*)(ws + WS_SIN);
      for (int i = obid() * 512 + tid; i < MT * 32; i += ogrid() * 512) {
          const int row = i >> 5, f = i & 31; const float ang = (float)pos[row] * p.inv_freq[f];
          double t = (double)ang * 0.15915494309189533577; t -= floor(t); const float tf = (float)t;
          ct[i] = __builtin_amdgcn_cosf(tf); st[i] = __builtin_amdgcn_sinf(tf); } }
    cvt_weights(p);
}

struct EpiGateUp { static constexpr bool PERM = true, AFTER_DRAIN = false;
    bf16_t* act; const float* ssq;
    DI void operator()(const f32x4 (&acc)[2][2][4][2], const Unit& u, int wr, int wc, int fr, int fq) const {
        const int row0 = u.pm * 256 + wr * 64 + fr, col0 = u.pn * 128 + wc * 32 + 8 * fq;
#pragma unroll
        for (int ai = 0; ai < 2; ++ai)
#pragma unroll
            for (int m = 0; m < 4; ++m) { const int row = row0 + ai * 128 + m * 16; const float rs = row_rstd(ssq, row);
                f32x4 a0, a1;
#pragma unroll
                for (int e = 0; e < 4; ++e) { a0[e] = silu_f(acc[ai][0][m][0][e] * rs) * (acc[ai][1][m][0][e] * rs); a1[e] = silu_f(acc[ai][0][m][1][e] * rs) * (acc[ai][1][m][1][e] * rs); }
                *(u32x4*)(act + (size_t)row * DFF + col0) = pack8(a0, a1); }
    }
};
struct EpiResid { static constexpr bool PERM = false, AFTER_DRAIN = false;
    float* x; bf16_t* xb; float* ssq_out; float alpha;
    DI void operator()(const f32x4 (&acc)[2][2][4][2], const Unit& u, int wr, int wc, int fr, int fq) const {
        const int row0 = u.pm * 256 + wr * 64 + fr, col0 = u.pn * 256 + wc * 32 + 4 * fq;
#pragma unroll
        for (int ai = 0; ai < 2; ++ai)
#pragma unroll
            for (int m = 0; m < 4; ++m) { const int row = row0 + ai * 128 + m * 16; float* xp = x + (size_t)row * 1024 + col0; bf16_t* bp = xb + (size_t)row * 1024 + col0; float s = 0.f;
#pragma unroll
                for (int bj = 0; bj < 2; ++bj)
#pragma unroll
                    for (int n = 0; n < 2; ++n) { f32x4 xv = *(const f32x4*)(xp + bj * 128 + n * 16); xv += alpha * acc[ai][bj][m][n]; *(f32x4*)(xp + bj * 128 + n * 16) = xv;
                        s += xv[0] * xv[0] + xv[1] * xv[1] + xv[2] * xv[2] + xv[3] * xv[3]; u32x2 w; w.x = pk2(xv[0], xv[1]); w.y = pk2(xv[2], xv[3]); *(u32x2*)(bp + bj * 128 + n * 16) = w; }
                s += __shfl_xor(s, 16); s += __shfl_xor(s, 32);
                if (fq == 0) ssq_out[(size_t)row * 16 + u.pn * 4 + wc] = s; }
    }
};
struct EpiGlaIn { static constexpr bool PERM = true, AFTER_DRAIN = false;
    bf16_t* G; const float* ssq;
    DI void operator()(const f32x4 (&acc)[2][2][4][2], const Unit& u, int wr, int wc, int fr, int fq) const {
        const int row0 = u.pm * 256 + wr * 64 + fr, col0 = u.pn * 256 + wc * 32 + 8 * fq; const float sc = u.pn < 2 ? 0.08838834764831845f : 1.0f;
#pragma unroll
        for (int ai = 0; ai < 2; ++ai)
#pragma unroll
            for (int m = 0; m < 4; ++m) { const int row = row0 + ai * 128 + m * 16; const float rs = row_rstd(ssq, row) * sc;
#pragma unroll
                for (int bj = 0; bj < 2; ++bj) *(u32x4*)(G + (size_t)row * 3072 + col0 + bj * 128) = pack8(acc[ai][bj][m][0] * rs, acc[ai][bj][m][1] * rs); }
    }
};
struct EpiMlaIn { static constexpr bool PERM = true, AFTER_DRAIN = false;
    bf16_t* cq; bf16_t* ckv; const float* ssq; float* ssq_qkv;
    DI void operator()(const f32x4 (&acc)[2][2][4][2], const Unit& u, int wr, int wc, int fr, int fq) const {
        const int row0 = u.pm * 256 + wr * 64 + fr, cw = wc * 32 + 8 * fq; const bool isq = u.pn < 3;
#pragma unroll
        for (int ai = 0; ai < 2; ++ai)
#pragma unroll
            for (int m = 0; m < 4; ++m) { const int row = row0 + ai * 128 + m * 16; const float rs = row_rstd(ssq, row); float s = 0.f;
                bf16_t* dst = isq ? cq + (size_t)row * 768 + u.pn * 256 + cw : ckv + (size_t)row * 256 + cw;
#pragma unroll
                for (int bj = 0; bj < 2; ++bj) { const f32x4 v0 = acc[ai][bj][m][0] * rs, v1 = acc[ai][bj][m][1] * rs;
                    s += v0[0] * v0[0] + v0[1] * v0[1] + v0[2] * v0[2] + v0[3] * v0[3] + v1[0] * v1[0] + v1[1] * v1[1] + v1[2] * v1[2] + v1[3] * v1[3];
                    *(u32x4*)(dst + bj * 128) = pack8(v0, v1); }
                s += __shfl_xor(s, 16); s += __shfl_xor(s, 32);
                if (fq == 0) ssq_qkv[(size_t)row * 16 + u.pn * 4 + wc] = s; }
    }
};
struct EpiUq { static constexpr bool PERM = true, AFTER_DRAIN = false;
    bf16_t* Q; const float* ssq_qkv; const float* ct; const float* st;
    DI void operator()(const f32x4 (&acc)[2][2][4][2], const Unit& u, int wr, int wc, int fr, int fq) const {
        const int row0 = u.pm * 256 + wr * 64 + fr;
#pragma unroll
        for (int ai = 0; ai < 2; ++ai)
#pragma unroll
            for (int m = 0; m < 4; ++m) { const int row = row0 + ai * 128 + m * 16; const float* sp = ssq_qkv + (size_t)row * 16; const f32x4 sa = *(const f32x4*)sp, sb = *(const f32x4*)(sp + 4), sc4 = *(const f32x4*)(sp + 8);
                const float rs = rsqrtf((((sa[0] + sa[1]) + (sa[2] + sa[3])) + ((sb[0] + sb[1]) + (sb[2] + sb[3])) + ((sc4[0] + sc4[1]) + (sc4[2] + sc4[3]))) * (1.0f / 768.0f) + EPS);
                const int b = row >> 11, s = row & 2047;
                if (u.pn < 4) {
#pragma unroll
                    for (int bj = 0; bj < 2; ++bj) { const int head = 2 * u.pn + bj;
                        *(u32x4*)(Q + ((size_t)(b * 8 + head) * SEQ + s) * 192 + wc * 32 + 8 * fq) = pack8(acc[ai][bj][m][0] * rs, acc[ai][bj][m][1] * rs); }
                } else {
                    const int i0 = 16 * (wc & 1) + 4 * fq;
                    const f32x4 c = *(const f32x4*)(ct + (size_t)row * 32 + i0), sn = *(const f32x4*)(st + (size_t)row * 32 + i0);
#pragma unroll
                    for (int bj = 0; bj < 2; ++bj) { const int head = 4 * (u.pn - 4) + 2 * bj + (wc >> 1);
                        const f32x4 v0 = acc[ai][bj][m][0] * rs, v1 = acc[ai][bj][m][1] * rs; f32x4 o0, o1;
                        o0[0] = v0[0] * c[0] - v0[1] * sn[0]; o0[1] = v0[1] * c[0] + v0[0] * sn[0];
                        o0[2] = v0[2] * c[1] - v0[3] * sn[1]; o0[3] = v0[3] * c[1] + v0[2] * sn[1];
                        o1[0] = v1[0] * c[2] - v1[1] * sn[2]; o1[1] = v1[1] * c[2] + v1[0] * sn[2];
                        o1[2] = v1[2] * c[3] - v1[3] * sn[3]; o1[3] = v1[3] * c[3] + v1[2] * sn[3];
                        *(u32x4*)(Q + ((size_t)(b * 8 + head) * SEQ + s) * 192 + 128 + 32 * (wc & 1) + 8 * fq) = pack8(o0, o1); }
                } }
    }
};
struct EpiUkv { static constexpr bool PERM = true, AFTER_DRAIN = false;
    bf16_t* Kb; bf16_t* Vb; const float* ssq_qkv;
    DI void operator()(const f32x4 (&acc)[2][2][4][2], const Unit& u, int wr, int wc, int fr, int fq) const {
        const int row0 = u.pm * 256 + wr * 64 + fr;
#pragma unroll
        for (int ai = 0; ai < 2; ++ai)
#pragma unroll
            for (int m = 0; m < 4; ++m) { const int row = row0 + ai * 128 + m * 16; const f32x4 sd = *(const f32x4*)(ssq_qkv + (size_t)row * 16 + 12); const float rs = rsqrtf(((sd[0] + sd[1]) + (sd[2] + sd[3])) * (1.0f / 256.0f) + EPS);
                const int b = row >> 11, s = row & 2047; const size_t tr = (size_t)(b * 8 + u.pn) * SEQ + s;
                *(u32x4*)(Kb + tr * 192 + wc * 32 + 8 * fq) = pack8(acc[ai][0][m][0] * rs, acc[ai][0][m][1] * rs);
                *(u32x4*)(Vb + tr * 128 + wc * 32 + 8 * fq) = pack8(acc[ai][1][m][0] * rs, acc[ai][1][m][1] * rs); }
    }
};
template <class Epi> DI void run_gemm(LAS unsigned char* lds, const bf16_t* A, const bf16_t* Bt, int N, int K, const Epi& E) {
    pg8::Gemm g; g.A = A; g.Bt = Bt; g.M = MT; g.N = N; g.K = K;
    pg8::StaticOrder S; S.init(MT, N, ogrid(), obid());
    pg8::gemm_phase<Epi, pg8::StaticOrder, false>(lds, g, S, E, nullptr);
}

template <int NBLK, int MODE> DI void skinny_gemm(const bf16_t* xb, const bf16_t* Bt, const float* ssq, float* gg, bf16_t* Kb, const float* ct, const float* st) {
    const int tid = otid(), lane = tid & 63, r = lane & 31, h = lane >> 5;
    const int wv = obid() * 8 + (tid >> 6), nwv = ogrid() * 8;
    for (int task = wv; task < MT / 32; task += nwv) {
        const int row0 = task * 32;
        f32x16 acc[NBLK];
#pragma unroll
        for (int nb = 0; nb < NBLK; ++nb)
#pragma unroll
            for (int i = 0; i < 16; ++i) acc[nb][i] = 0.f;
        const bf16_t* ap = xb + (size_t)(row0 + r) * 1024 + 8 * h;
        const bf16_t* bp = Bt + (size_t)r * 1024 + 8 * h;
#pragma unroll 8
        for (int k0 = 0; k0 < 1024; k0 += 16) {
            const bf16x8 a = *(const bf16x8*)(ap + k0);
#pragma unroll
            for (int nb = 0; nb < NBLK; ++nb) { const bf16x8 b = *(const bf16x8*)(bp + (size_t)nb * 32 * 1024 + k0);
                acc[nb] = __builtin_amdgcn_mfma_f32_32x32x16_bf16(a, b, acc[nb], 0, 0, 0); }
        }
#pragma unroll
        for (int i = 0; i < 16; ++i) { const int row = row0 + (i & 3) + 8 * (i >> 2) + 4 * h; const float rs = row_rstd(ssq, row);
            if (MODE == 0) { gg[(size_t)row * 32 + r] = acc[0][i] * rs; }
            else { const float x1 = acc[0][i] * rs, x2 = acc[NBLK - 1][i] * rs, c = ct[(size_t)row * 32 + r], sn = st[(size_t)row * 32 + r];
                const unsigned w = pk2(x1 * c - x2 * sn, x2 * c + x1 * sn); const int b = row >> 11, s = row & 2047;
#pragma unroll
                for (int hd = 0; hd < 8; ++hd) *(unsigned*)(Kb + ((size_t)(b * 8 + hd) * SEQ + s) * 192 + 128 + 2 * r) = w; } }
    }
}
namespace att {
constexpr int DQ = 192, DV = 128, NW = 8, QBLK = 32, KVBLK = 64;
constexpr float SCALE = 0.07216878364870322f;
constexpr float THR = 8.f;
constexpr int SHM_V = KVBLK * DV * 2, SHM_K = KVBLK * DQ * 2, SHM_ATTN = 2 * SHM_V + 2 * SHM_K + NW * 64 * 4;
#define KSWZ(row, colB) ((row) * 384 + ((colB) ^ (((row) & 7) << 4)))
#define SBAR() __builtin_amdgcn_sched_barrier(0)
DI int crow(int r, int hi) { return (r & 3) + 8 * (r >> 2) + 4 * hi; }
DI void partialSM(f32x16& p0, f32x16& p1, float& m_reg, float& mn, float& alpha) {
    constexpr float C = SCALE * 1.4426950408889634f;
    float pmax = p0[0];
#pragma unroll
    for (int r = 1; r < 16; ++r) pmax = fmaxf(pmax, p0[r]);
#pragma unroll
    for (int r = 0; r < 16; ++r) pmax = fmaxf(pmax, p1[r]);
    { auto rr = __builtin_amdgcn_permlane32_swap(__float_as_uint(pmax), __float_as_uint(pmax), false, false);
      pmax = fmaxf(__uint_as_float(rr[0]), __uint_as_float(rr[1])); }
    if (__builtin_expect(__all(pmax - m_reg <= THR / SCALE), 1)) { mn = m_reg; alpha = 1.f; }
    else { mn = fmaxf(m_reg, pmax); alpha = __builtin_amdgcn_exp2f((m_reg - mn) * C); m_reg = mn; }
    const float mnC = -mn * C;
#pragma unroll
    for (int r = 0; r < 16; ++r) p0[r] = fmaf(p0[r], C, mnC);
#pragma unroll
    for (int r = 0; r < 16; ++r) p1[r] = fmaf(p1[r], C, mnC);
#pragma unroll
    for (int r = 0; r < 16; ++r) p0[r] = __builtin_amdgcn_exp2f(p0[r]);
}
DI void finishSM(f32x16& p0, f32x16& p1, float alpha, float& l_reg, bf16x8& pa0, bf16x8& pa1, bf16x8& pa2, bf16x8& pa3) {
#pragma unroll
    for (int r = 0; r < 16; ++r) p1[r] = __builtin_amdgcn_exp2f(p1[r]);
    float ps = 0;
#pragma unroll
    for (int r = 0; r < 16; ++r) ps += p0[r];
#pragma unroll
    for (int r = 0; r < 16; ++r) ps += p1[r];
    { auto rr = __builtin_amdgcn_permlane32_swap(__float_as_uint(ps), __float_as_uint(ps), false, false);
      ps = __uint_as_float(rr[0]) + __uint_as_float(rr[1]); }
    l_reg = l_reg * alpha + ps;
#define PK4(P, BASE, OUT) do { unsigned a0 = pk2(P[BASE + 0], P[BASE + 1]), a1 = pk2(P[BASE + 2], P[BASE + 3]);   \
    unsigned b0 = pk2(P[BASE + 4], P[BASE + 5]), b1 = pk2(P[BASE + 6], P[BASE + 7]);                              \
    auto r0 = __builtin_amdgcn_permlane32_swap(a0, b0, false, false); auto r1 = __builtin_amdgcn_permlane32_swap(a1, b1, false, false); \
    u32x4 w = {r0[0], r1[0], r0[1], r1[1]}; OUT = __builtin_bit_cast(bf16x8, w); } while (0)
    PK4(p0, 0, pa0); PK4(p0, 8, pa1); PK4(p1, 0, pa2); PK4(p1, 8, pa3);
#undef PK4
}
DI void qkt(f32x16& p0, f32x16& p1, const char* Ks, const int (&kb)[4], const bf16x8* qr) {
#pragma unroll
    for (int i = 0; i < 16; ++i) { p0[i] = 0.f; p1[i] = 0.f; }
#pragma unroll
    for (int d0 = 0; d0 < 12; ++d0) {
        const bf16x8 b0 = *reinterpret_cast<const bf16x8*>(Ks + kb[d0 & 3] + (d0 >> 2) * 128);
        const bf16x8 b1 = *reinterpret_cast<const bf16x8*>(Ks + kb[d0 & 3] + (d0 >> 2) * 128 + 32 * 384);
        p0 = __builtin_amdgcn_mfma_f32_32x32x16_bf16(b0, qr[d0], p0, 0, 0, 0);
        p1 = __builtin_amdgcn_mfma_f32_32x32x16_bf16(b1, qr[d0], p1, 0, 0, 0); }
}
DI int v_st(int k, int c) { const int kk = (k & ~0xC) | ((k & 4) << 1) | ((k & 8) >> 1); return ((kk >> 3) * 4 + (c >> 5)) * 512 + ((kk & 7) * 32 + (c & 31)) * 2; }
DI int v_rd_base(int lane) { return ((lane & 3) << 3) | (((lane >> 2) & 3) << 6) | (((lane >> 4) & 1) << 5) | (((lane >> 5) & 1) << 8); }
constexpr int v_rd_off(int d0, int ks, int half) { return d0 * 512 + ks * 4096 + half * 2048; }
template <int OFF> DI s16x4 tr_read(int vb) { s16x4 r; asm volatile("ds_read_b64_tr_b16 %0, %1 offset:%2" : "=&v"(r) : "v"(vb), "i"(OFF) : "memory"); return r; }
template <int D0> DI void pv_one(f32x16& od, int vb, bf16x8 pa0, bf16x8 pa1, bf16x8 pa2, bf16x8 pa3) {
    const s16x4 l0 = tr_read<v_rd_off(D0, 0, 0)>(vb), h0 = tr_read<v_rd_off(D0, 0, 1)>(vb), l1 = tr_read<v_rd_off(D0, 1, 0)>(vb), h1 = tr_read<v_rd_off(D0, 1, 1)>(vb);
    const s16x4 l2 = tr_read<v_rd_off(D0, 2, 0)>(vb), h2 = tr_read<v_rd_off(D0, 2, 1)>(vb), l3 = tr_read<v_rd_off(D0, 3, 0)>(vb), h3 = tr_read<v_rd_off(D0, 3, 1)>(vb);
    asm volatile("s_waitcnt lgkmcnt(0)" ::: "memory"); SBAR();
#define PKV(L, H) (bf16x8){L[0], L[1], L[2], L[3], H[0], H[1], H[2], H[3]}
    od = __builtin_amdgcn_mfma_f32_32x32x16_bf16(pa0, PKV(l0, h0), od, 0, 0, 0);
    od = __builtin_amdgcn_mfma_f32_32x32x16_bf16(pa1, PKV(l1, h1), od, 0, 0, 0);
    od = __builtin_amdgcn_mfma_f32_32x32x16_bf16(pa2, PKV(l2, h2), od, 0, 0, 0);
    od = __builtin_amdgcn_mfma_f32_32x32x16_bf16(pa3, PKV(l3, h3), od, 0, 0, 0);
#undef PKV
}
DI void pv_d0(f32x16* o, int vb, bf16x8 pa0, bf16x8 pa1, bf16x8 pa2, bf16x8 pa3) {
    pv_one<0>(o[0], vb, pa0, pa1, pa2, pa3); pv_one<1>(o[1], vb, pa0, pa1, pa2, pa3); pv_one<2>(o[2], vb, pa0, pa1, pa2, pa3); pv_one<3>(o[3], vb, pa0, pa1, pa2, pa3);
}
DI void attn_body(const bf16_t* __restrict__ Qb, const bf16_t* __restrict__ Kh, const bf16_t* __restrict__ Vh, bf16_t* __restrict__ Ob, int seq, char* lds) {
    const int tid = otid(), wid = tid >> 6, lane = tid & 63, r32 = lane & 31, hi = lane >> 5;
    char* V_lds = lds; char* K_lds = lds + 2 * SHM_V;
    float* ws = (float*)(lds + 2 * SHM_V + 2 * SHM_K) + wid * 64; float* li_l = ws; float* al_l = ws + 32;
    float m_reg = -1e30f, l_reg = 0; f32x16 o[4];
#pragma unroll
    for (int d = 0; d < 4; ++d)
#pragma unroll
        for (int r = 0; r < 16; ++r) o[d][r] = 0.f;
    bf16x8 qr[12];
    const bf16_t* Qw = Qb + (size_t)(wid * QBLK + r32) * DQ + hi * 8;
#pragma unroll
    for (int d0 = 0; d0 < 12; ++d0) qr[d0] = *(const bf16x8*)(Qw + d0 * 16);
    const int sr = tid >> 4, sc = (tid & 15) * 8, vst0 = v_st(sr, sc), vst1 = v_st(32 + sr, sc);
    int krow_[3], kcp_[3];
#pragma unroll
    for (int i = 0; i < 3; ++i) { const int pc = tid + 512 * i; krow_[i] = pc / 24; kcp_[i] = pc % 24; }
    const int vb0 = (int)(uintptr_t)V_lds + v_rd_base(lane);
    int kb[4];
#pragma unroll
    for (int b = 0; b < 4; ++b) kb[b] = r32 * 384 + ((b * 32 + hi * 16) ^ ((r32 & 7) << 4));
    bf16x8 vs0, vs1, ks0, ks1, ks2;
#define SLOAD(k0) do { vs0 = *(const bf16x8*)(Vh + (size_t)((k0) + sr) * DV + sc); vs1 = *(const bf16x8*)(Vh + (size_t)((k0) + 32 + sr) * DV + sc); \
    ks0 = *(const bf16x8*)(Kh + (size_t)((k0) + krow_[0]) * DQ + kcp_[0] * 8); ks1 = *(const bf16x8*)(Kh + (size_t)((k0) + krow_[1]) * DQ + kcp_[1] * 8); \
    ks2 = *(const bf16x8*)(Kh + (size_t)((k0) + krow_[2]) * DQ + kcp_[2] * 8); } while (0)
#define SWRITE(b) do { *(bf16x8*)(V_lds + (b) * SHM_V + vst0) = vs0; *(bf16x8*)(V_lds + (b) * SHM_V + vst1) = vs1; \
    *(bf16x8*)(K_lds + (b) * SHM_K + KSWZ(krow_[0], kcp_[0] * 16)) = ks0; *(bf16x8*)(K_lds + (b) * SHM_K + KSWZ(krow_[1], kcp_[1] * 16)) = ks1; \
    *(bf16x8*)(K_lds + (b) * SHM_K + KSWZ(krow_[2], kcp_[2] * 16)) = ks2; } while (0)
#define RESC(a) do { if (__any((a) < 1.f)) { if (hi == 0) al_l[r32] = (a); asm volatile("s_waitcnt lgkmcnt(0)" ::: "memory"); \
    _Pragma("unroll") for (int d = 0; d < 4; ++d) _Pragma("unroll") for (int r = 0; r < 16; ++r) o[d][r] *= al_l[crow(r, hi)]; } } while (0)
    f32x16 p0, p1; float mn, al; bf16x8 pa0, pa1, pa2, pa3; const int NT = seq / KVBLK;
    SLOAD(0); SWRITE(0); __syncthreads();
    for (int j = 0; j < NT; ++j) {
        const int bsel = j & 1;
        if (j + 1 < NT) SLOAD((j + 1) * KVBLK);
        SBAR(); qkt(p0, p1, K_lds + bsel * SHM_K, kb, qr);
        partialSM(p0, p1, m_reg, mn, al);
        RESC(al);
        finishSM(p0, p1, al, l_reg, pa0, pa1, pa2, pa3); SBAR();
        pv_d0(o, vb0 + bsel * SHM_V, pa0, pa1, pa2, pa3);
        if (j + 1 < NT) SWRITE(bsel ^ 1);
        __syncthreads();
    }
    if (hi == 0) li_l[r32] = l_reg; asm volatile("s_waitcnt lgkmcnt(0)" ::: "memory");
    float rli[16];
#pragma unroll
    for (int r = 0; r < 16; ++r) rli[r] = __builtin_amdgcn_rcpf(li_l[crow(r, hi)]);
    bf16_t* Ow = Ob + (size_t)(wid * QBLK) * 1024;
#pragma unroll
    for (int r = 0; r < 16; ++r) { const int orow = crow(r, hi);
#pragma unroll
        for (int d0 = 0; d0 < 4; ++d0) { const unsigned w = pk2(o[d0][r] * rli[r], 0.f); Ow[(size_t)orow * 1024 + d0 * 32 + r32] = (bf16_t)(w & 0xffffu); } }
    __syncthreads();
#undef SLOAD
#undef SWRITE
#undef RESC
}
}
DI void gla_scan_naive(const Params& p, int j, unsigned char* lds) {
    const int tid = otid(); unsigned char* ws = lws(p);
    const bf16_t* G = (const bf16_t*)(ws + WS_G); const float* gg = (const float*)(ws + WS_GG);
    const float* w2 = IN(p, I_GLA_WG2) + (size_t)j * 2 * 16 * 512; const float* bg = IN(p, I_GLA_BG) + (size_t)j * 2 * 512;
    float* Lq = (float*)lds; float* Lk = Lq + 64 * 128; float* La = Lk + 64 * 128; bf16_t* Lv = (bf16_t*)(La + 64 * 128);
    for (int unit = obid(); unit < 64; unit += ogrid()) {
        const int b = unit >> 3, h = (unit >> 1) & 3, dir = unit & 1;
        bf16_t* ob = (bf16_t*)(ws + (dir ? WS_OBW : WS_OFW));
        float S[128];
#pragma unroll
        for (int d = 0; d < 128; ++d) S[d] = 0.f;
        for (int c = 0; c < 32; ++c) {
            __syncthreads();
            for (int idx = tid; idx < 64 * 128; idx += 512) { const int t = idx >> 7, d = idx & 127; const int tok = dir ? (SEQ - 1 - (64 * c + t)) : (64 * c + t); const size_t row = (size_t)b * SEQ + tok;
                Lq[idx] = bf2f(G[row * 3072 + h * 128 + d]); Lk[idx] = bf2f(G[row * 3072 + 512 + h * 128 + d]);
                float z = bg[dir * 512 + h * 128 + d];
#pragma unroll
                for (int jj = 0; jj < 16; ++jj) z += gg[row * 32 + dir * 16 + jj] * w2[(dir * 16 + jj) * 512 + h * 128 + d];
                const float ls = fminf(z, 0.f) - __logf(1.0f + __expf(-fabsf(z)));
                La[idx] = __expf(ls * (1.0f / 16.0f)); }
            for (int idx = tid; idx < 64 * 256; idx += 512) { const int t = idx >> 8, dv = idx & 255; const int tok = dir ? (SEQ - 1 - (64 * c + t)) : (64 * c + t); const size_t row = (size_t)b * SEQ + tok;
                Lv[idx] = G[row * 3072 + 1024 + h * 256 + dv]; }
            __syncthreads();
            if (tid < 256) {
                for (int t = 0; t < 64; ++t) {
                    const float v = bf2f(Lv[t * 256 + tid]); float o = 0.f;
                    const f32x4* qa = (const f32x4*)(Lq + t * 128); const f32x4* ka = (const f32x4*)(Lk + t * 128); const f32x4* aa = (const f32x4*)(La + t * 128);
#pragma unroll
                    for (int d4 = 0; d4 < 32; ++d4) { const f32x4 q4 = qa[d4], k4 = ka[d4], a4 = aa[d4];
#pragma unroll
                        for (int e = 0; e < 4; ++e) { const int d = d4 * 4 + e; const float sd = a4[e] * S[d];
                            if (dir == 0) { S[d] = sd + k4[e] * v; o += q4[e] * S[d]; } else { o += q4[e] * sd; S[d] = sd + k4[e] * v; } } }
                    const int tok = dir ? (SEQ - 1 - (64 * c + t)) : (64 * c + t);
                    ob[((size_t)b * SEQ + tok) * 1024 + h * 256 + tid] = (bf16_t)(pk2(o, 0.f) & 0xffffu);
                }
            }
        }
    }
}
DI void gla_gated_norm(const Params& p, int j) {
    const int tid = otid(), lane = tid & 63, l = lane & 31; unsigned char* ws = lws(p);
    const bf16_t* ofw = (const bf16_t*)(ws + WS_OFW); const bf16_t* obw = (const bf16_t*)(ws + WS_OBW); const bf16_t* G = (const bf16_t*)(ws + WS_G); bf16_t* on = (bf16_t*)(ws + WS_ON);
    const float* hn = IN(p, I_GLA_HN) + j * 256;
    const int wv = obid() * 8 + (tid >> 6), nwv = ogrid() * 8;
    float g8[8];
#pragma unroll
    for (int e = 0; e < 8; ++e) g8[e] = hn[l * 8 + e];
    for (int pr = wv; pr < MT * 2; pr += nwv) {
        const int rh = pr * 2 + (lane >> 5), row = rh >> 2, h = rh & 3; const size_t off = (size_t)row * 1024 + h * 256 + l * 8;
        const u32x4 a = *(const u32x4*)(ofw + off), bq = *(const u32x4*)(obw + off), rr = *(const u32x4*)(G + (size_t)row * 3072 + 2048 + h * 256 + l * 8);
        float o[8], rv[8];
#pragma unroll
        for (int e = 0; e < 4; ++e) { o[2 * e] = bflo(a[e]) + bflo(bq[e]); o[2 * e + 1] = bfhi(a[e]) + bfhi(bq[e]); rv[2 * e] = bflo(rr[e]); rv[2 * e + 1] = bfhi(rr[e]); }
        float ss = 0.f;
#pragma unroll
        for (int e = 0; e < 8; ++e) ss += o[e] * o[e];
#pragma unroll
        for (int s = 16; s >= 1; s >>= 1) ss += __shfl_xor(ss, s);
        const float rs = rsqrtf(ss * (1.0f / 256.0f) + EPS);
        float y[8];
#pragma unroll
        for (int e = 0; e < 8; ++e) y[e] = o[e] * rs * g8[e] * silu_f(rv[e]);
        u32x4 w; w.x = pk2(y[0], y[1]); w.y = pk2(y[2], y[3]); w.z = pk2(y[4], y[5]); w.w = pk2(y[6], y[7]);
        *(u32x4*)(on + off) = w;
    }
}
DI void final_norm(const Params& p) {
    const int tid = otid(), lane = tid & 63; unsigned char* ws = lws(p);
    const float* xres = (const float*)(ws + WS_XRES); const float* ssq = (const float*)(ws + WS_SSQ) + (size_t)12 * MT * 16; const float* g = IN(p, I_FINAL_NORM);
    const int wv = obid() * 8 + (tid >> 6), nwv = ogrid() * 8;
    for (int row = wv; row < MT; row += nwv) { const float rs = row_rstd(ssq, row);
#pragma unroll
        for (int i = 0; i < 4; ++i) { const f32x4 v = ((const f32x4*)(xres + (size_t)row * 1024))[lane + 64 * i]; const f32x4 gv = ((const f32x4*)g)[lane + 64 * i];
            ((f32x4*)(lout(p) + (size_t)row * 1024))[lane + 64 * i] = v * rs * gv; } }
}

DI void run_phase(const Params& p, int ph, unsigned char* shm) {
    unsigned char* ws = lws(p); LAS unsigned char* lds = (LAS unsigned char*)shm;
    float* xres = (float*)(ws + WS_XRES); bf16_t* xb = (bf16_t*)(ws + WS_XB); bf16_t* act = (bf16_t*)(ws + WS_ACT); float* ssq = (float*)(ws + WS_SSQ);
    if (ph == 0) { prep_phase(p); return; }
    if (ph == 33) { final_norm(p); return; }
    const int li = (ph - 1) >> 3, sub = (ph - 1) & 7, j = li >> 1; const bool mla = li & 1;
    if (sub == 0 || sub == 6) { const int s = sub == 6; EpiGateUp E; E.act = act; E.ssq = ssq + (size_t)(3 * li + (s ? 2 : 0)) * MT * 16;
        run_gemm(lds, xb, (const bf16_t*)(ws + WS_WGU + (size_t)(li * 2 + s) * SZ_WGU), 5632, 1024, E); return; }
    if (sub == 1 || sub == 7) { const int s = sub == 7; EpiResid E; E.x = xres; E.xb = xb; E.ssq_out = ssq + (size_t)(3 * li + (s ? 3 : 1)) * MT * 16; E.alpha = 0.5f;
        run_gemm(lds, act, (const bf16_t*)(ws + WS_WD + (size_t)(li * 2 + s) * SZ_WD), 1024, 2816, E); return; }
    const float* ssq_mix = ssq + (size_t)(3 * li + 1) * MT * 16;
    if (!mla) {
        if (sub == 2) { skinny_gemm<1, 0>(xb, (const bf16_t*)(ws + WS_GWG + (size_t)j * 32 * 1024 * 2), ssq_mix, (float*)(ws + WS_GG), nullptr, nullptr, nullptr);
            __syncthreads();
            EpiGlaIn E; E.G = (bf16_t*)(ws + WS_G); E.ssq = ssq_mix; run_gemm(lds, xb, (const bf16_t*)(ws + WS_GWIN + (size_t)j * 3072 * 1024 * 2), 3072, 1024, E); return; }
        if (sub == 3) { gla_scan_naive(p, j, shm); return; }
        if (sub == 4) { gla_gated_norm(p, j); return; }
        if (sub == 5) { EpiResid E; E.x = xres; E.xb = xb; E.ssq_out = ssq + (size_t)(3 * li + 2) * MT * 16; E.alpha = 1.0f;
            run_gemm(lds, (const bf16_t*)(ws + WS_ON), (const bf16_t*)(ws + WS_GWOUT + (size_t)j * 1024 * 1024 * 2), 1024, 1024, E); return; }
    } else {
        float* ssq_qkv = (float*)(ws + WS_SSQQ) + (size_t)j * MT * 16;
        const float* ct = (const float*)(ws + WS_COS); const float* st = (const float*)(ws + WS_SIN);
        if (sub == 2) { skinny_gemm<2, 1>(xb, (const bf16_t*)(ws + WS_MWKPE + (size_t)j * 64 * 1024 * 2), ssq_mix, nullptr, (bf16_t*)(ws + WS_KB), ct, st);
            __syncthreads();
            EpiMlaIn E; E.cq = (bf16_t*)(ws + WS_CQ); E.ckv = (bf16_t*)(ws + WS_CKV); E.ssq = ssq_mix; E.ssq_qkv = ssq_qkv;
            run_gemm(lds, xb, (const bf16_t*)(ws + WS_MWIN + (size_t)j * 1024 * 1024 * 2), 1024, 1024, E); return; }
        if (sub == 3) { { EpiUq E; E.Q = (bf16_t*)(ws + WS_Q); E.ssq_qkv = ssq_qkv; E.ct = ct; E.st = st;
              run_gemm(lds, (const bf16_t*)(ws + WS_CQ), (const bf16_t*)(ws + WS_MWUQ + (size_t)j * 1536 * 768 * 2), 1536, 768, E); }
            __syncthreads();
            { EpiUkv E; E.Kb = (bf16_t*)(ws + WS_KB); E.Vb = (bf16_t*)(ws + WS_VB); E.ssq_qkv = ssq_qkv;
              run_gemm(lds, (const bf16_t*)(ws + WS_CKV), (const bf16_t*)(ws + WS_MWUKV + (size_t)j * 2048 * 256 * 2), 2048, 256, E); }
            return; }
        if (sub == 4) { const bf16_t* Q = (const bf16_t*)(ws + WS_Q); const bf16_t* Kb = (const bf16_t*)(ws + WS_KB); const bf16_t* Vb = (const bf16_t*)(ws + WS_VB); bf16_t* O = (bf16_t*)(ws + WS_O);
            for (int U = obid(); U < 512; U += ogrid()) { const int bh = (U & 7) + 8 * (U >> 6), qb = (U >> 3) & 7, b = bh >> 3, h = bh & 7;
                att::attn_body(Q + ((size_t)bh * SEQ + qb * 256) * 192, Kb + (size_t)bh * SEQ * 192, Vb + (size_t)bh * SEQ * 128, O + ((size_t)b * SEQ + qb * 256) * 1024 + h * 128, SEQ, (char*)shm); }
            return; }
        if (sub == 5) { EpiResid E; E.x = xres; E.xb = xb; E.ssq_out = ssq + (size_t)(3 * li + 2) * MT * 16; E.alpha = 1.0f;
            run_gemm(lds, (const bf16_t*)(ws + WS_O), (const bf16_t*)(ws + WS_MWOUT + (size_t)j * 1024 * 1024 * 2), 1024, 1024, E); return; }
    }
}
__global__ void __launch_bounds__(512, 2) mega_fwd(Params p) {
    extern __shared__ __attribute__((aligned(16))) unsigned char shm[];
    cg::grid_group grid = cg::this_grid();
    for (int ph = p.ph_lo; ph < p.ph_hi; ++ph) {
        run_phase(p, ph, shm);
        if (ph + 1 < p.ph_hi) {
            __builtin_amdgcn_fence(__ATOMIC_SEQ_CST, "agent"); asm volatile("s_waitcnt vmcnt(0) lgkmcnt(0)" ::: "memory");
            grid.sync();
            __builtin_amdgcn_fence(__ATOMIC_SEQ_CST, "agent"); asm volatile("s_waitcnt vmcnt(0) lgkmcnt(0)" ::: "memory");
        }
    }
}

extern "C" void kernel_launch(void* const* d_in, const int* in_sizes, int n_in, void* d_out, int out_size, void* d_ws, size_t ws_size, hipStream_t stream) {
    static int grid = 0;
    if (grid == 0) {
        if (n_in != 18 || out_size != MT * DM || ws_size < WS_END) { fprintf(stderr, "kernel_launch: unexpected shapes (n_in %d out %d ws %zu need %zu)\n", n_in, out_size, ws_size, (size_t)WS_END); grid = -1; return; }
        int dev = 0, cus = 0, per_cu = 0;
        if (hipGetDevice(&dev) != hipSuccess || hipDeviceGetAttribute(&cus, hipDeviceAttributeMultiprocessorCount, dev) != hipSuccess) { grid = -1; return; }
        if (hipFuncSetAttribute((const void*)mega_fwd, hipFuncAttributeMaxDynamicSharedMemorySize, LDS_BYTES) != hipSuccess) { fprintf(stderr, "kernel_launch: hipFuncSetAttribute failed\n"); grid = -1; return; }
        if (hipOccupancyMaxActiveBlocksPerMultiprocessor(&per_cu, (const void*)mega_fwd, 512, LDS_BYTES) != hipSuccess || per_cu < 1) { fprintf(stderr, "kernel_launch: occupancy query says %d\n", per_cu); per_cu = 1; }
        (void)hipGetLastError();
        grid = cus;
    }
    if (grid < 0) return;
    Params p{};
    for (int i = 0; i < 18; ++i) p.in[i] = (const float*)d_in[i];
    p.out = (float*)d_out; p.ws = (unsigned char*)d_ws;
    for (int i = 0; i < 32; ++i) p.inv_freq[i] = 1.0f / powf(10000.0f, (float)(2 * i) / 64.0f);
#ifndef MK_PER_PHASE
#define MK_PER_PHASE 0
#endif
    const int nl = MK_PER_PHASE ? 34 : 1;
    for (int li = 0; li < nl; ++li) {
        p.ph_lo = MK_PER_PHASE ? li : 0; p.ph_hi = MK_PER_PHASE ? li + 1 : 34;
        void* args[] = {&p};
        hipError_t e = hipLaunchCooperativeKernel((const void*)mega_fwd, dim3(grid), dim3(512), args, LDS_BYTES, stream);
        if (e != hipSuccess) { fprintf(stderr, "kernel_launch: cooperative launch failed: %s (grid %d)\n", hipGetErrorString(e), grid); break; }
    }
}
```

```cpp
#include <hip/hip_runtime.h>
#include <hip/hip_cooperative_groups.h>
#include <cstdio>
#include <cmath>
namespace cg = cooperative_groups;
__device__ __forceinline__ int otid() { int t = threadIdx.x; asm volatile("" : "+v"(t)); return t; }
__device__ __forceinline__ int obid() { int b = blockIdx.x; asm volatile("" : "+s"(b)); return b; }
__device__ __forceinline__ int ogrid() { int g = gridDim.x; asm volatile("" : "+s"(g)); return g; }
namespace pg8 {
#define PG8_LAS __attribute__((address_space(3)))
typedef unsigned short bf16_t;
typedef short bf16x8 __attribute__((ext_vector_type(8)));
typedef float f32x4 __attribute__((ext_vector_type(4)));
typedef unsigned u32x4 __attribute__((ext_vector_type(4)));
constexpr int BM = 256, BK = 64, HALF = 128, HTB = HALF * BK * 2  , STAGE_BYTES = 8 * HTB, NXCD = 8, WGM = 8;

__host__ __device__ __forceinline__ int lds_byte(int r, int c) { const int st = (r >> 4) * 2 + (c >> 5), rr = r & 15, cc = c & 31, ob = rr * 64 + cc * 2; return st * 1024 + (ob ^ (((ob >> 9) & 1) << 5)); }
__host__ __device__ __forceinline__ void stage_rc(int b, int& R, int& C) { const int st = b / 1024, sb = b % 1024, swz = sb ^ (((sb >> 9) & 1) << 5); R = (st >> 1) * 16 + swz / 64; C = (st & 1) * 32 + (swz % 64) / 2; }
__host__ __device__ __forceinline__ int perm32(int rho) { const int n = rho >> 4, i = rho & 15; return 8 * (i >> 2) + 4 * n + (i & 3); }

struct Unit { int pm, pn; };
struct Gemm { const bf16_t* A; const bf16_t* Bt; int M, N, K; };

struct StaticOrder {
    int nM, nN, nwg, G, c;
    __host__ __device__ void init(int M, int N, int G_, int c_) { nM = M / BM; nN = N / BM; nwg = nM * nN; G = G_; c = c_; }
    __host__ __device__ bool next(int i, Unit& u) const {
        const long L = (long)i * G + c; if (L >= nwg) return false;
        int wgid = (int)L; { const int q = nwg / NXCD, r = nwg % NXCD, xcd = wgid % NXCD, off = wgid / NXCD; wgid = (xcd < r ? xcd * (q + 1) : r * (q + 1) + (xcd - r) * q) + off; }
        const int nig = WGM * nN, gid = wgid / nig, fm = gid * WGM, gsz = (nM - fm) < WGM ? (nM - fm) : WGM;
        u.pm = fm + ((wgid % nig) % gsz); u.pn = (wgid % nig) / gsz; return true;
    }
    __device__ __forceinline__ void a_ready(const Unit&) const {}
    __device__ __forceinline__ void done(const Unit&) const {}
};
template <class Epi, class Sched, bool STAMP = false>
__device__ __forceinline__ void gemm_phase(PG8_LAS unsigned char* lds, const Gemm g, const Sched& S, const Epi& E, unsigned long long* stamps) {
    const int tid = otid(), wid = __builtin_amdgcn_readfirstlane(tid >> 6), lane = tid & 63, wr = wid >> 2, wc = wid & 3, fr = lane & 15, fq = lane >> 4;
    const int K = g.K, nt = K / BK;
    int ts_lo = 0, ts_hi = 0, nts = 0; const unsigned long long rt_entry = STAMP ? (unsigned long long)wall_clock64() : 0ull;
#define PG8_STAMP() do { if (STAMP && wid == 0 && nts < 64) { const unsigned long long _c = (unsigned long long)clock64(); \
        ts_lo = (lane == nts) ? (int)(unsigned)_c : ts_lo; ts_hi = (lane == nts) ? (int)(unsigned)(_c >> 32) : ts_hi; ++nts; } } while (0)
    PG8_STAMP();
    unsigned voffA[2], voffB[2];
#pragma unroll
    for (int i = 0; i < 2; ++i) { int R, C; stage_rc(tid * 16 + i * 8192, R, C); const int Rb = Epi::PERM ? ((R & ~31) + perm32(R & 31)) : R;
        voffA[i] = (unsigned)(R * K + C) * 2u; voffB[i] = (unsigned)(Rb * K + C) * 2u; }
    const size_t kstep = (size_t)(BK * 2);
    const size_t hstep = (size_t)HALF * K * 2;
    const size_t tstep = 2 * hstep;
    const unsigned ldsw = (unsigned)wid * 1024u;
    const int aoff = lds_byte(wr * 64 + fr, fq * 8), boff = lds_byte(wc * 32 + fr, fq * 8);
#define PG8_SA(b, h) (((b) * 2 + (h)) * HTB)
#define PG8_SB(b, h) ((4 + (b) * 2 + (h)) * HTB)
#define PG8_STAGE(bufoff, gbase, voff) do { _Pragma("unroll") for (int _i = 0; _i < 2; ++_i) \
        __builtin_amdgcn_global_load_lds((const unsigned*)((const char*)(gbase) + (voff)[_i]), (PG8_LAS unsigned*)(lds + (bufoff) + ldsw + _i * 8192), 16, 0, 0); } while (0)
#define PG8_LDA(dst, b, h) do { _Pragma("unroll") for (int m = 0; m < 4; ++m) _Pragma("unroll") for (int k = 0; k < 2; ++k) dst[m][k] = *(const PG8_LAS bf16x8*)(lds + PG8_SA(b, h) + aoff + m * 2048 + k * 1024); } while (0)
#define PG8_LDB(dst, b, h) do { _Pragma("unroll") for (int n = 0; n < 2; ++n) _Pragma("unroll") for (int k = 0; k < 2; ++k) dst[n][k] = *(const PG8_LAS bf16x8*)(lds + PG8_SB(b, h) + boff + n * 2048 + k * 1024); } while (0)
#define PG8_MMA(ai, bj, At, Bt) do { __builtin_amdgcn_s_setprio(1); _Pragma("unroll") for (int m = 0; m < 4; ++m) _Pragma("unroll") for (int n = 0; n < 2; ++n) _Pragma("unroll") for (int k = 0; k < 2; ++k) \
        acc[ai][bj][m][n] = __builtin_amdgcn_mfma_f32_16x16x32_bf16(Bt[n][k], At[m][k], acc[ai][bj][m][n], 0, 0, 0); __builtin_amdgcn_s_setprio(0); } while (0)
#define PG8_WAIT_V(n) asm volatile("s_waitcnt vmcnt(" #n ")" ::: "memory")
#define PG8_WAIT_L(n) asm volatile("s_waitcnt lgkmcnt(" #n ")" ::: "memory")
#define PG8_BAR __builtin_amdgcn_s_barrier()
#define PG8_SCHED __builtin_amdgcn_sched_barrier(0)
    Unit cur, nxt; int ui = 0;
    if (!S.next(0, cur)) return;
    f32x4 acc[2][2][4][2];
#pragma unroll
    for (int a = 0; a < 2; ++a)
#pragma unroll
        for (int b = 0; b < 2; ++b)
#pragma unroll
            for (int m = 0; m < 4; ++m)
#pragma unroll
                for (int n = 0; n < 2; ++n) acc[a][b][m][n] = (f32x4){0.f, 0.f, 0.f, 0.f};
    bf16x8 At[4][2], B0[2][2], B1[2][2];
    const char* cA = (const char*)g.A + (size_t)cur.pm * tstep; const char* cB = (const char*)g.Bt + (size_t)cur.pn * tstep;
    S.a_ready(cur);
    PG8_STAGE(PG8_SB(0, 0), cB, voffB); PG8_STAGE(PG8_SA(0, 0), cA, voffA); PG8_STAGE(PG8_SB(0, 1), cB + hstep, voffB); PG8_STAGE(PG8_SA(0, 1), cA + hstep, voffA);
    if (wr == 1) PG8_BAR;
    PG8_WAIT_V(4); PG8_BAR;
    PG8_STAGE(PG8_SB(1, 0), cB + kstep, voffB); PG8_STAGE(PG8_SA(1, 0), cA + kstep, voffA); PG8_STAGE(PG8_SB(1, 1), cB + hstep + kstep, voffB);
    PG8_WAIT_V(6); PG8_BAR;
    PG8_STAMP();
    for (;;) {
        const bool has_next = S.next(ui + 1, nxt);
        const char* nA = has_next ? (const char*)g.A + (size_t)nxt.pm * tstep : cA; const char* nB = has_next ? (const char*)g.Bt + (size_t)nxt.pn * tstep : cB;
        for (int t = 0; t < nt; t += 2) {
            const bool last = (t == nt - 2);
            const char* a1 = cA + (size_t)(t + 1) * kstep;
            const char* a2 = last ? nA : cA + (size_t)(t + 2) * kstep; const char* b2 = last ? nB : cB + (size_t)(t + 2) * kstep;
            const char* a3 = a2 + kstep; const char* b3 = b2 + kstep;
            if (last && has_next) S.a_ready(nxt);
            PG8_LDB(B0, 0, 0); PG8_SCHED; PG8_LDA(At, 0, 0); PG8_STAGE(PG8_SA(1, 1), a1 + hstep, voffA);
            PG8_WAIT_L(8); PG8_BAR; PG8_WAIT_L(0); PG8_MMA(0, 0, At, B0); PG8_BAR; PG8_SCHED;
            PG8_LDB(B1, 0, 1); PG8_STAGE(PG8_SB(0, 0), b2, voffB);
            PG8_BAR; PG8_WAIT_L(0); PG8_MMA(0, 1, At, B1); PG8_BAR;
            PG8_LDA(At, 0, 1); PG8_STAGE(PG8_SA(0, 0), a2, voffA);
            PG8_BAR; PG8_WAIT_L(0); PG8_MMA(1, 0, At, B0); PG8_BAR; PG8_SCHED;
            PG8_STAGE(PG8_SB(0, 1), b2 + hstep, voffB);
            PG8_WAIT_V(6); PG8_BAR; PG8_MMA(1, 1, At, B1); PG8_BAR;
            PG8_LDB(B0, 1, 0); PG8_SCHED; PG8_LDA(At, 1, 0); PG8_STAGE(PG8_SA(0, 1), a2 + hstep, voffA);
            PG8_WAIT_L(8); PG8_BAR; PG8_WAIT_L(0); PG8_MMA(0, 0, At, B0); PG8_BAR; PG8_SCHED;
            PG8_LDB(B1, 1, 1); PG8_STAGE(PG8_SB(1, 0), b3, voffB);
            PG8_BAR; PG8_WAIT_L(0); PG8_MMA(0, 1, At, B1); PG8_BAR;
            PG8_LDA(At, 1, 1); PG8_STAGE(PG8_SA(1, 0), a3, voffA);
            PG8_BAR; PG8_WAIT_L(0); PG8_MMA(1, 0, At, B0); PG8_BAR; PG8_SCHED;
            PG8_STAGE(PG8_SB(1, 1), b3 + hstep, voffB);
            PG8_WAIT_V(6); PG8_BAR; PG8_MMA(1, 1, At, B1); PG8_BAR;
        }
        PG8_STAMP();
        if constexpr (!Epi::AFTER_DRAIN) { E(acc, cur, wr, wc, fr, fq); S.done(cur); }
        PG8_STAMP();
        if (!has_next) break;
#pragma unroll
        for (int a = 0; a < 2; ++a)
#pragma unroll
            for (int b = 0; b < 2; ++b)
#pragma unroll
                for (int m = 0; m < 4; ++m)
#pragma unroll
                    for (int n = 0; n < 2; ++n) acc[a][b][m][n] = (f32x4){0.f, 0.f, 0.f, 0.f};
        cur = nxt; cA = nA; cB = nB; ++ui;
    }
    PG8_WAIT_V(0);
    if (wr == 0) PG8_BAR;
    PG8_BAR;
    if constexpr (Epi::AFTER_DRAIN) { E.fused(acc, cur, wr, wc, fr, fq, lds, wid, lane); S.done(cur); }
    PG8_STAMP();
    if (STAMP && wid == 0) { stamps[lane] = lane < nts ? (((unsigned long long)(unsigned)ts_hi << 32) | (unsigned)ts_lo) : 0ull;
        if (lane == 62) stamps[62] = rt_entry; if (lane == 63) stamps[63] = (unsigned long long)wall_clock64(); }
#undef PG8_STAMP
#undef PG8_SA
#undef PG8_SB
#undef PG8_STAGE
#undef PG8_LDA
#undef PG8_LDB
#undef PG8_MMA
#undef PG8_WAIT_V
#undef PG8_WAIT_L
#undef PG8_BAR
#undef PG8_SCHED
}
}
using pg8::bf16_t; using pg8::bf16x8; using pg8::f32x4; using pg8::u32x4; using pg8::Unit;
typedef float f32x16 __attribute__((ext_vector_type(16)));
typedef float f32x2 __attribute__((ext_vector_type(2)));
typedef unsigned u32x2 __attribute__((ext_vector_type(2)));
typedef short s16x4 __attribute__((ext_vector_type(4)));
typedef __bf16 bf16x2v __attribute__((ext_vector_type(2)));
#define DI __device__ __forceinline__
#define LAS __attribute__((address_space(3)))

constexpr int MT = 16384, DM = 1024, DFF = 2816, SEQ = 2048, NBATCH = 8;
constexpr int GLA_N = 3104, MLA_N = 1088;
constexpr float EPS = 1e-6f;
constexpr int LDS_BYTES = 147456;
constexpr int LDS_XB_OFF = LDS_BYTES - 16;
constexpr int LDS_DUMMY = 0;

constexpr size_t SZ_WGU = (size_t)5632 * 1024 * 2, SZ_WD = (size_t)1024 * 2816 * 2;
constexpr size_t WS_WGU = 0;
constexpr size_t WS_WD = WS_WGU + 8 * SZ_WGU;
constexpr size_t WS_GWIN = WS_WD + 8 * SZ_WD;
constexpr size_t WS_GWG = WS_GWIN + 2 * (size_t)3072 * 1024 * 2;
constexpr size_t WS_GWOUT = WS_GWG + 2 * (size_t)32 * 1024 * 2;
constexpr size_t WS_MWIN = WS_GWOUT + 2 * (size_t)1024 * 1024 * 2;
constexpr size_t WS_MWKPE = WS_MWIN + 2 * (size_t)1024 * 1024 * 2;
constexpr size_t WS_MWUQ = WS_MWKPE + 2 * (size_t)64 * 1024 * 2;
constexpr size_t WS_MWUKV = WS_MWUQ + 2 * (size_t)1536 * 768 * 2;
constexpr size_t WS_MWOUT = WS_MWUKV + 2 * (size_t)2048 * 256 * 2;
constexpr size_t WS_XRES = WS_MWOUT + 2 * (size_t)1024 * 1024 * 2;
constexpr size_t WS_XB = WS_XRES + (size_t)MT * 1024 * 4;
constexpr size_t WS_ACT = WS_XB + (size_t)MT * 1024 * 2;
constexpr size_t WS_SSQ = WS_ACT + (size_t)MT * 2816 * 2;
constexpr size_t WS_SSQQ = WS_SSQ + (size_t)13 * MT * 16 * 4;
constexpr size_t WS_COS = WS_SSQQ + (size_t)2 * MT * 16 * 4;
constexpr size_t WS_SIN = WS_COS + (size_t)MT * 32 * 4;
constexpr size_t WS_MIX = WS_SIN + (size_t)MT * 32 * 4;
constexpr size_t WS_G = WS_MIX;
constexpr size_t WS_GG = WS_G + (size_t)MT * 3072 * 2;
constexpr size_t WS_OFW = WS_GG + (size_t)MT * 32 * 4;
constexpr size_t WS_OBW = WS_OFW + (size_t)MT * 1024 * 2;
constexpr size_t WS_ON = WS_OBW + (size_t)MT * 1024 * 2;
constexpr size_t WS_GIMG = WS_ON + (size_t)MT * 1024 * 2;
constexpr size_t WS_GLA_END = WS_GIMG + (size_t)2048 * 49664;
constexpr size_t WS_CQ = WS_MIX;
constexpr size_t WS_CKV = WS_CQ + (size_t)MT * 768 * 2;
constexpr size_t WS_Q = WS_CKV + (size_t)MT * 256 * 2;
constexpr size_t WS_KB = WS_Q + (size_t)MT * 8 * 192 * 2;
constexpr size_t WS_VB = WS_KB + (size_t)MT * 8 * 192 * 2;
constexpr size_t WS_O = WS_VB + (size_t)MT * 8 * 128 * 2;
constexpr size_t WS_MLA_END = WS_O + (size_t)MT * 1024 * 2;
constexpr size_t WS_BAR = WS_GLA_END > WS_MLA_END ? WS_GLA_END : WS_MLA_END;
constexpr size_t WS_BAR_BYTES = 3456 * 4;
constexpr size_t WS_END = WS_BAR + WS_BAR_BYTES;

struct Params {
    const float* in[18];
    float* out;
    unsigned char* ws;
    float inv_freq[32];
    int ph_lo, ph_hi;
};
enum { I_X = 0, I_POS, I_FFN_NORM, I_FFN_WGU, I_FFN_WD, I_MIX_NORM, I_GLA_WIN, I_GLA_WG2, I_GLA_BG, I_GLA_HN, I_GLA_WOUT,
       I_MLA_WIN, I_MLA_QN, I_MLA_KVN, I_MLA_WUQ, I_MLA_WUKV, I_MLA_WOUT, I_FINAL_NORM };

DI unsigned pk2(float a, float b) { f32x2 v = {a, b}; bf16x2v r = __builtin_convertvector(v, bf16x2v); return __builtin_bit_cast(unsigned, r); }
DI float bf2f(bf16_t v) { return __uint_as_float(((unsigned)v) << 16); }
DI float bflo(unsigned w) { return __uint_as_float(w << 16); }
DI float bfhi(unsigned w) { return __uint_as_float(w & 0xffff0000u); }
DI float silu_f(float g) { return g * __builtin_amdgcn_rcpf(1.0f + __expf(-g)); }
DI u32x4 pack8(const f32x4& a, const f32x4& b) { u32x4 w; w.x = pk2(a[0], a[1]); w.y = pk2(a[2], a[3]); w.z = pk2(b[0], b[1]); w.w = pk2(b[2], b[3]); return w; }
DI unsigned char* lws(const Params& p) { unsigned char* w = p.ws; asm volatile("" : "+s"(w)); return w; }
DI float* lout(const Params& p) { float* w = p.out; asm volatile("" : "+s"(w)); return w; }
DI const float* IN(const Params& p, int i) { const float* w = p.in[i]; asm volatile("" : "+s"(w)); return w; }
DI float sum16(const float* s) { const f32x4 a = *(const f32x4*)s, b = *(const f32x4*)(s + 4), c = *(const f32x4*)(s + 8), d = *(const f32x4*)(s + 12);
    return ((a[0] + a[1]) + (a[2] + a[3])) + ((b[0] + b[1]) + (b[2] + b[3])) + ((c[0] + c[1]) + (c[2] + c[3])) + ((d[0] + d[1]) + (d[2] + d[3])); }
DI float row_rstd(const float* ssqp, int row) { return rsqrtf(sum16(ssqp + (size_t)row * 16) * (1.0f / 1024.0f) + EPS); }
#define XB_TMO      128
#define XB_XCNT(j)  (256  + 64 * (j))
#define XB_XSUB(j)  (1280 + 64 * (j))
#define XB_XGEN(j)  (2304 + 64 * (j))
#define XB_TOP      3328
#define XB_TOPGEN   3392
#define XCD_BAR_WORDS 3456
#define XB_SPIN_CAP (1u << 22)

__device__ __forceinline__ unsigned xb_ld(unsigned* p)              { return __hip_atomic_load(p, __ATOMIC_RELAXED, __HIP_MEMORY_SCOPE_AGENT); }
__device__ __forceinline__ unsigned xb_add(unsigned* p, unsigned v) { return __hip_atomic_fetch_add(p, v, __ATOMIC_RELAXED, __HIP_MEMORY_SCOPE_AGENT); }
__device__ __forceinline__ unsigned xb_xcc_id() { return (unsigned)__builtin_amdgcn_s_getreg((3 << 11) | 20) & 0xFu; }
#define XB_SPIN(cond, bar) do { unsigned _sp = 0; while (cond) { __builtin_amdgcn_s_sleep(1); \
    if ((++_sp & 255u) == 0u) { if (xb_ld(&(bar)[XB_TMO])) break; if (_sp > XB_SPIN_CAP) { atomicAdd(&(bar)[XB_TMO], 1u); break; } } } } while (0)

struct XcdBarrier {
    unsigned* bar; unsigned x;
    volatile LAS unsigned* st;
};

__device__ __forceinline__ XcdBarrier xcd_barrier_post(unsigned* bar, volatile LAS unsigned* st) {
    XcdBarrier b; b.bar = bar; b.x = xb_xcc_id(); b.st = st;
    if (threadIdx.x == 0) (void)xb_add(&bar[XB_XCNT(b.x)], 1u);
    return b;
}
__device__ __forceinline__ void xcd_barrier_complete(unsigned* bar, unsigned x, unsigned& nloc, unsigned& nx) {
    const unsigned G = gridDim.x * gridDim.y * gridDim.z;
    unsigned sum, cnt, mine, sp = 0u;
    for (;;) {
        sum = 0u; cnt = 0u; mine = 0u;
#pragma unroll
        for (unsigned j = 0; j < 16; ++j) { const unsigned c = xb_ld(&bar[XB_XCNT(j)]); sum += c; cnt += (c > 0u) ? 1u : 0u; mine = (j == x) ? c : mine; }
        if (sum == G) break;
        __builtin_amdgcn_s_sleep(1);
        if ((++sp & 255u) == 0u) { if (xb_ld(&bar[XB_TMO])) break; if (sp > XB_SPIN_CAP) { atomicAdd(&bar[XB_TMO], 1u); break; } }
    }
    nloc = mine > 0u ? mine : 1u; nx = cnt > 0u ? cnt : 1u;
}

__device__ __forceinline__ void xcd_barrier(const XcdBarrier& b) {
    asm volatile("s_waitcnt vmcnt(0)" ::: "memory");
    __syncthreads();
    if (threadIdx.x == 0) {
        unsigned* bar = b.bar;
        __builtin_amdgcn_s_waitcnt(0);
        unsigned nloc = b.st[0], nx = b.st[1];
        if (nloc == 0u) { xcd_barrier_complete(bar, b.x, nloc, nx); b.st[0] = nloc; b.st[1] = nx; }
        const unsigned old = xb_add(&bar[XB_XSUB(b.x)], 1u);
        const unsigned gen = old / nloc;
        if (old + 1u == (gen + 1u) * nloc) {
            __builtin_amdgcn_fence(__ATOMIC_RELEASE, "agent");
            asm volatile("s_waitcnt vmcnt(0)" ::: "memory");
            const unsigned og = xb_add(&bar[XB_TOP], 1u);
            const unsigned tg = og / nx;
            if (og + 1u == (tg + 1u) * nx) xb_add(&bar[XB_TOPGEN], 1u);
            else XB_SPIN(xb_ld(&bar[XB_TOPGEN]) == tg, bar);
            __builtin_amdgcn_fence(__ATOMIC_ACQUIRE, "agent");
            xb_add(&bar[XB_XGEN(b.x)], 1u);
            asm volatile("s_waitcnt vmcnt(0)" ::: "memory");
        } else {
            XB_SPIN(xb_ld(&bar[XB_XGEN(b.x)]) == gen, bar);
            __builtin_amdgcn_fence(__ATOMIC_ACQUIRE, "agent");
            asm volatile("s_waitcnt vmcnt(0)" ::: "memory");
        }
    }
    __syncthreads();
}

struct CvtJob { const float* src; const float* gain; bf16_t* dst; int K, ldn, N, mode, coloff; };
DI int cvt_map(int mode, int coloff, int n) {
    if (mode == 1) { const int pn = n >> 8, bj = (n >> 7) & 1, i = n & 127; return bj * DFF + pn * 128 + i; }
    if (mode == 2) { if (n < 1024) return (n >> 7) * 192 + (n & 127); const int cr = n - 1024, head = cr >> 6, idx = cr & 63; return head * 192 + 128 + (idx & 1) * 32 + (idx >> 1); }
    return coloff + n;
}
DI CvtJob get_job(const Params& p, int idx) {
    CvtJob j; j.gain = nullptr; j.mode = 0; j.coloff = 0;
    unsigned char* ws = lws(p);
    if (idx < 16) { const int t = idx >> 1;
        if ((idx & 1) == 0) { j.src = IN(p, I_FFN_WGU) + (size_t)t * 1024 * 5632; j.gain = IN(p, I_FFN_NORM) + t * 1024; j.dst = (bf16_t*)(ws + WS_WGU + t * SZ_WGU); j.K = 1024; j.ldn = 5632; j.N = 5632; j.mode = 1; }
        else { j.src = IN(p, I_FFN_WD) + (size_t)t * 2816 * 1024; j.dst = (bf16_t*)(ws + WS_WD + t * SZ_WD); j.K = 2816; j.ldn = 1024; j.N = 1024; }
    } else if (idx < 22) { const int g = (idx - 16) / 3, w = (idx - 16) % 3;
        if (w == 0) { j.src = IN(p, I_GLA_WIN) + (size_t)g * 1024 * GLA_N; j.gain = IN(p, I_MIX_NORM) + (2 * g) * 1024; j.dst = (bf16_t*)(ws + WS_GWIN + (size_t)g * 3072 * 1024 * 2); j.K = 1024; j.ldn = GLA_N; j.N = 3072; }
        else if (w == 1) { j.src = IN(p, I_GLA_WIN) + (size_t)g * 1024 * GLA_N; j.gain = IN(p, I_MIX_NORM) + (2 * g) * 1024; j.dst = (bf16_t*)(ws + WS_GWG + (size_t)g * 32 * 1024 * 2); j.K = 1024; j.ldn = GLA_N; j.N = 32; j.coloff = 3072; }
        else { j.src = IN(p, I_GLA_WOUT) + (size_t)g * 1024 * 1024; j.dst = (bf16_t*)(ws + WS_GWOUT + (size_t)g * 1024 * 1024 * 2); j.K = 1024; j.ldn = 1024; j.N = 1024; }
    } else { const int g = (idx - 22) / 5, w = (idx - 22) % 5;
        if (w == 0) { j.src = IN(p, I_MLA_WIN) + (size_t)g * 1024 * MLA_N; j.gain = IN(p, I_MIX_NORM) + (2 * g + 1) * 1024; j.dst = (bf16_t*)(ws + WS_MWIN + (size_t)g * 1024 * 1024 * 2); j.K = 1024; j.ldn = MLA_N; j.N = 1024; }
        else if (w == 1) { j.src = IN(p, I_MLA_WIN) + (size_t)g * 1024 * MLA_N; j.gain = IN(p, I_MIX_NORM) + (2 * g + 1) * 1024; j.dst = (bf16_t*)(ws + WS_MWKPE + (size_t)g * 64 * 1024 * 2); j.K = 1024; j.ldn = MLA_N; j.N = 64; j.coloff = 1024; }
        else if (w == 2) { j.src = IN(p, I_MLA_WUQ) + (size_t)g * 768 * 1536; j.gain = IN(p, I_MLA_QN) + g * 768; j.dst = (bf16_t*)(ws + WS_MWUQ + (size_t)g * 1536 * 768 * 2); j.K = 768; j.ldn = 1536; j.N = 1536; j.mode = 2; }
        else if (w == 3) { j.src = IN(p, I_MLA_WUKV) + (size_t)g * 256 * 2048; j.gain = IN(p, I_MLA_KVN) + g * 256; j.dst = (bf16_t*)(ws + WS_MWUKV + (size_t)g * 2048 * 256 * 2); j.K = 256; j.ldn = 2048; j.N = 2048; }
        else { j.src = IN(p, I_MLA_WOUT) + (size_t)g * 1024 * 1024; j.dst = (bf16_t*)(ws + WS_MWOUT + (size_t)g * 1024 * 1024 * 2); j.K = 1024; j.ldn = 1024; j.N = 1024; }
    }
    return j;
}
constexpr unsigned CVT_L0 = 0x00030003u, CVT_S0 = 0x07fc03fcu, CVT_S2 = 0xf800fc00u;
static_assert((CVT_L0 | CVT_S0 | CVT_S2) == 0xffffffffu && (CVT_L0 & CVT_S0) == 0u && (CVT_L0 & CVT_S2) == 0u && (CVT_S0 & CVT_S2) == 0u, "job sets");
DI void cvt_weights(const Params& p, unsigned mask, int b0, int nb) {
    const int tid = otid(), nn = tid & 31, kk = tid >> 5;
    for (int ji = 0; ji < 32; ++ji) {
        if (!((mask >> ji) & 1u)) continue;
        const CvtJob j = get_job(p, ji);
        const int ntk = j.K >> 7, ntn = j.N >> 5, nt = ntk * ntn;
        for (int t = obid() - b0; t < nt; t += nb) {
            const int tn = t % ntn, tk = t / ntn;
            const int n = tn * 32 + nn, k0 = tk * 128 + kk * 8;
            const int sc = cvt_map(j.mode, j.coloff, n);
            const float* sp = j.src + (size_t)k0 * j.ldn + sc;
            float v[8];
#pragma unroll
            for (int e = 0; e < 8; ++e) v[e] = sp[(size_t)e * j.ldn];
            if (j.gain) {
#pragma unroll
                for (int e = 0; e < 8; ++e) v[e] *= j.gain[k0 + e];
            }
            u32x4 w; w.x = pk2(v[0], v[1]); w.y = pk2(v[2], v[3]); w.z = pk2(v[4], v[5]); w.w = pk2(v[6], v[7]);
            *(u32x4*)(j.dst + (size_t)n * j.K + k0) = w;
        }
    }
}
DI void prep_phase(const Params& p) {
    const int tid = otid(), lane = tid & 63, wv = obid() * 8 + (tid >> 6), nwv = ogrid() * 8;
    unsigned char* ws = lws(p);
    { const float* x = IN(p, I_X); bf16_t* xb = (bf16_t*)(ws + WS_XB); float* ssq0 = (float*)(ws + WS_SSQ);
      for (int row = wv; row < MT; row += nwv) {
          const f32x4* s = (const f32x4*)(x + (size_t)row * 1024); float ss = 0.f;
#pragma unroll
          for (int i = 0; i < 4; ++i) { const f32x4 v = s[lane + 64 * i]; u32x2 w; w.x = pk2(v[0], v[1]); w.y = pk2(v[2], v[3]);
              ss += (bflo(w.x) * bflo(w.x) + bfhi(w.x) * bfhi(w.x)) + (bflo(w.y) * bflo(w.y) + bfhi(w.y) * bfhi(w.y));
              ((u32x2*)(xb + (size_t)row * 1024))[lane + 64 * i] = w; }
#pragma unroll
          for (int o = 32; o >= 1; o >>= 1) ss += __shfl_xor(ss, o);
          if (lane < 16) ssq0[(size_t)row * 16 + lane] = lane == 0 ? ss : 0.f;
      } }
    { const int* pos = (const int*)IN(p, I_POS); float* ct = (float*)(ws + WS_COS); float* st = (float*)(ws + WS_SIN);
      for (int i = obid() * 512 + tid; i < MT * 32; i += ogrid() * 512) {
          const int row = i >> 5, f = i & 31; const float ang = (float)pos[row] * p.inv_freq[f];
          double t = (double)ang * 0.15915494309189533577; t -= floor(t); const float tf = (float)t;
          ct[i] = __builtin_amdgcn_cosf(tf); st[i] = __builtin_amdgcn_sinf(tf); } }
    cvt_weights(p, ogrid() > 64 ? CVT_L0 : 0xffffffffu, 0, ogrid());
}

constexpr int LDS_RTAB = 131072, LDS_PMTAB = LDS_RTAB + 6 * 256 * 4;
static_assert(LDS_PMTAB + 32 <= LDS_XB_OFF, "rstd table");
struct RstdTab { const float* r; const int* pm;
    DI int slot(int upm) const { int s = 0;
#pragma unroll
        for (int i = 5; i >= 0; --i) s = (pm[i] == upm) ? i : s;
        return s; }
    DI float get(int s, int rowin) const { return r[s * 256 + rowin]; } };
DI RstdTab fill_rstd(unsigned char* shm, int N, const float* ssqp, int slot0, int nslots, float invn) {
    float* rt = (float*)(shm + LDS_RTAB); int* pt = (int*)(shm + LDS_PMTAB);
    const int tid = otid(), half = tid >> 8, rowin = tid & 255;
    pg8::StaticOrder S; S.init(MT, N, ogrid(), obid());
    __syncthreads();
    for (int i0 = 0; i0 < 6; i0 += 2) { const int i = i0 + half; Unit u; u.pm = 0; u.pn = 0; const bool ok = S.next(i, u);
        if (rowin == 0) pt[i] = ok ? u.pm : -1;
        if (ok) { const float* sp = ssqp + (size_t)(u.pm * 256 + rowin) * 16 + slot0; float s = 0.f;
            for (int k = 0; k < nslots; k += 4) { const f32x4 v = *(const f32x4*)(sp + k); s += (v[0] + v[1]) + (v[2] + v[3]); }
            rt[i * 256 + rowin] = rsqrtf(s * invn + EPS); } }
    __syncthreads();
    RstdTab t; t.r = rt; t.pm = pt; return t;
}

struct EpiGateUp { static constexpr bool PERM = true, AFTER_DRAIN = false;
    bf16_t* act; RstdTab rt;
    DI void operator()(const f32x4 (&acc)[2][2][4][2], const Unit& u, int wr, int wc, int fr, int fq) const {
        const int row0 = u.pm * 256 + wr * 64 + fr, col0 = u.pn * 128 + wc * 32 + 8 * fq; const int ts = rt.slot(u.pm);
#pragma unroll
        for (int ai = 0; ai < 2; ++ai)
#pragma unroll
            for (int m = 0; m < 4; ++m) { const int row = row0 + ai * 128 + m * 16; const float rs = rt.get(ts, row & 255);
                f32x4 a0, a1;
#pragma unroll
                for (int e = 0; e < 4; ++e) { a0[e] = silu_f(acc[ai][0][m][0][e] * rs) * (acc[ai][1][m][0][e] * rs); a1[e] = silu_f(acc[ai][0][m][1][e] * rs) * (acc[ai][1][m][1][e] * rs); }
                *(u32x4*)(act + (size_t)row * DFF + col0) = pack8(a0, a1); }
    }
};
struct EpiResid { static constexpr bool PERM = true, AFTER_DRAIN = false;
    bf16_t* xb; float* ssq_out; float alpha;
    DI void operator()(const f32x4 (&acc)[2][2][4][2], const Unit& u, int wr, int wc, int fr, int fq) const {
        const int row0 = u.pm * 256 + wr * 64 + fr, col0 = u.pn * 256 + wc * 32 + 8 * fq;
        const __amdgpu_buffer_rsrc_t xrs = __builtin_amdgcn_make_buffer_rsrc(xb, 0, MT * 1024 * 2, 0x00020000);
#pragma unroll
        for (int ai = 0; ai < 2; ++ai) {
            u32x4 xin[4][2];
#pragma unroll
            for (int m = 0; m < 4; ++m) { const bf16_t* bp = xb + (size_t)(row0 + ai * 128 + m * 16) * 1024 + col0; xin[m][0] = *(const u32x4*)bp; xin[m][1] = *(const u32x4*)(bp + 128); }
#pragma unroll
            for (int m = 0; m < 4; ++m) { const int row = row0 + ai * 128 + m * 16; bf16_t* bp = xb + (size_t)row * 1024 + col0; float s = 0.f;
#pragma unroll
                for (int bj = 0; bj < 2; ++bj) { const u32x4 xi = xin[m][bj]; f32x4 x0, x1;
                    x0[0] = bflo(xi[0]); x0[1] = bfhi(xi[0]); x0[2] = bflo(xi[1]); x0[3] = bfhi(xi[1]); x1[0] = bflo(xi[2]); x1[1] = bfhi(xi[2]); x1[2] = bflo(xi[3]); x1[3] = bfhi(xi[3]);
                    x0 += alpha * acc[ai][bj][m][0]; x1 += alpha * acc[ai][bj][m][1];
                    const u32x4 w = pack8(x0, x1); __builtin_amdgcn_raw_buffer_store_b128(w, xrs, (unsigned)(((size_t)row * 1024 + col0 + bj * 128) * 2), 0, 16);
#pragma unroll
                    for (int e = 0; e < 4; ++e) { const float lo = bflo(w[e]), hi = bfhi(w[e]); s += lo * lo + hi * hi; } }
                s += __shfl_xor(s, 16); s += __shfl_xor(s, 32);
                if (fq == 0) ssq_out[(size_t)row * 16 + u.pn * 4 + wc] = s; }
        }
    }
};
struct EpiGlaIn { static constexpr bool PERM = true, AFTER_DRAIN = false;
    bf16_t* G; RstdTab rt;
    DI void operator()(const f32x4 (&acc)[2][2][4][2], const Unit& u, int wr, int wc, int fr, int fq) const {
        const int row0 = u.pm * 256 + wr * 64 + fr, col0 = u.pn * 256 + wc * 32 + 8 * fq; const float sc = u.pn < 2 ? 0.08838834764831845f : 1.0f; const int ts = rt.slot(u.pm);
#pragma unroll
        for (int ai = 0; ai < 2; ++ai)
#pragma unroll
            for (int m = 0; m < 4; ++m) { const int row = row0 + ai * 128 + m * 16; const float rs = rt.get(ts, row & 255) * sc;
#pragma unroll
                for (int bj = 0; bj < 2; ++bj) *(u32x4*)(G + (size_t)row * 3072 + col0 + bj * 128) = pack8(acc[ai][bj][m][0] * rs, acc[ai][bj][m][1] * rs); }
    }
};
struct EpiMlaIn { static constexpr bool PERM = true, AFTER_DRAIN = false;
    bf16_t* cq; bf16_t* ckv; RstdTab rt; float* ssq_qkv;
    DI void operator()(const f32x4 (&acc)[2][2][4][2], const Unit& u, int wr, int wc, int fr, int fq) const {
        const int row0 = u.pm * 256 + wr * 64 + fr, cw = wc * 32 + 8 * fq; const bool isq = u.pn < 3; const int ts = rt.slot(u.pm);
#pragma unroll
        for (int ai = 0; ai < 2; ++ai)
#pragma unroll
            for (int m = 0; m < 4; ++m) { const int row = row0 + ai * 128 + m * 16; const float rs = rt.get(ts, row & 255); float s = 0.f;
                bf16_t* dst = isq ? cq + (size_t)row * 768 + u.pn * 256 + cw : ckv + (size_t)row * 256 + cw;
#pragma unroll
                for (int bj = 0; bj < 2; ++bj) { const f32x4 v0 = acc[ai][bj][m][0] * rs, v1 = acc[ai][bj][m][1] * rs;
                    s += v0[0] * v0[0] + v0[1] * v0[1] + v0[2] * v0[2] + v0[3] * v0[3] + v1[0] * v1[0] + v1[1] * v1[1] + v1[2] * v1[2] + v1[3] * v1[3];
                    *(u32x4*)(dst + bj * 128) = pack8(v0, v1); }
                s += __shfl_xor(s, 16); s += __shfl_xor(s, 32);
                if (fq == 0) ssq_qkv[(size_t)row * 16 + u.pn * 4 + wc] = s; }
    }
};
struct EpiUq { static constexpr bool PERM = true, AFTER_DRAIN = false;
    bf16_t* Q; RstdTab rt; const float* ct; const float* st;
    DI void operator()(const f32x4 (&acc)[2][2][4][2], const Unit& u, int wr, int wc, int fr, int fq) const {
        const int row0 = u.pm * 256 + wr * 64 + fr; const int ts = rt.slot(u.pm);
        if (u.pn < 4) {
#pragma unroll
            for (int ai = 0; ai < 2; ++ai)
#pragma unroll
                for (int m = 0; m < 4; ++m) { const int row = row0 + ai * 128 + m * 16; const float rs = rt.get(ts, row & 255); const int b = row >> 11, s = row & 2047;
#pragma unroll
                    for (int bj = 0; bj < 2; ++bj) { const int head = 2 * u.pn + bj;
                        *(u32x4*)(Q + ((size_t)(b * 8 + head) * SEQ + s) * 192 + wc * 32 + 8 * fq) = pack8(acc[ai][bj][m][0] * rs, acc[ai][bj][m][1] * rs); } }
        } else {
            const int i0 = 16 * (wc & 1) + 4 * fq;
#pragma unroll
            for (int ai = 0; ai < 2; ++ai)
#pragma unroll
                for (int m = 0; m < 4; ++m) { const int row = row0 + ai * 128 + m * 16; const float rs = rt.get(ts, row & 255); const int b = row >> 11, s = row & 2047;
                    const f32x4 c = *(const f32x4*)(ct + (size_t)row * 32 + i0) * rs, sn = *(const f32x4*)(st + (size_t)row * 32 + i0) * rs;
#pragma unroll
                    for (int bj = 0; bj < 2; ++bj) { const int head = 4 * (u.pn - 4) + 2 * bj + (wc >> 1);
                        const f32x4 v0 = acc[ai][bj][m][0], v1 = acc[ai][bj][m][1]; f32x4 o0, o1;
                        o0[0] = v0[0] * c[0] - v0[1] * sn[0]; o0[1] = v0[1] * c[0] + v0[0] * sn[0];
                        o0[2] = v0[2] * c[1] - v0[3] * sn[1]; o0[3] = v0[3] * c[1] + v0[2] * sn[1];
                        o1[0] = v1[0] * c[2] - v1[1] * sn[2]; o1[1] = v1[1] * c[2] + v1[0] * sn[2];
                        o1[2] = v1[2] * c[3] - v1[3] * sn[3]; o1[3] = v1[3] * c[3] + v1[2] * sn[3];
                        *(u32x4*)(Q + ((size_t)(b * 8 + head) * SEQ + s) * 192 + 128 + 32 * (wc & 1) + 8 * fq) = pack8(o0, o1); }
                    asm volatile("" ::: "memory"); }
        }
    }
};
struct EpiUkv { static constexpr bool PERM = true, AFTER_DRAIN = false;
    bf16_t* Kb; bf16_t* Vb; RstdTab rt;
    DI void operator()(const f32x4 (&acc)[2][2][4][2], const Unit& u, int wr, int wc, int fr, int fq) const {
        const int row0 = u.pm * 256 + wr * 64 + fr; const int ts = rt.slot(u.pm);
#pragma unroll
        for (int ai = 0; ai < 2; ++ai)
#pragma unroll
            for (int m = 0; m < 4; ++m) { const int row = row0 + ai * 128 + m * 16; const float rs = rt.get(ts, row & 255);
                const int b = row >> 11, s = row & 2047; const size_t tr = (size_t)(b * 8 + u.pn) * SEQ + s;
                *(u32x4*)(Kb + tr * 192 + wc * 32 + 8 * fq) = pack8(acc[ai][0][m][0] * rs, acc[ai][0][m][1] * rs);
                *(u32x4*)(Vb + tr * 128 + wc * 32 + 8 * fq) = pack8(acc[ai][1][m][0] * rs, acc[ai][1][m][1] * rs); }
    }
};
template <class Epi> DI void run_gemm(LAS unsigned char* lds, const bf16_t* A, const bf16_t* Bt, int N, int K, const Epi& E) {
    asm volatile("" : "+s"(K));
    pg8::Gemm g; g.A = A; g.Bt = Bt; g.M = MT; g.N = N; g.K = K;
    pg8::StaticOrder S; S.init(MT, N, ogrid(), obid());
    pg8::gemm_phase<Epi, pg8::StaticOrder, false>(lds, g, S, E, nullptr);
}

template <int NBLK, int MODE> DI void skinny_gemm(const bf16_t* xb, const bf16_t* Bt, const float* ssq, float* gg, bf16_t* Kb, const float* ct, const float* st, unsigned char* lds) {
    const int tid = otid(), lane = tid & 63, w = tid >> 6, r = lane & 31, h = lane >> 5, rt = w >> 2, kq = w & 3;
    float* red = (float*)lds;
    for (int rb = obid(); rb < MT / 64; rb += ogrid()) {
        const int row0 = rb * 64 + rt * 32;
        f32x16 acc[NBLK];
#pragma unroll
        for (int nb = 0; nb < NBLK; ++nb)
#pragma unroll
            for (int i = 0; i < 16; ++i) acc[nb][i] = 0.f;
        const bf16_t* ap = xb + (size_t)(row0 + r) * 1024 + kq * 256 + 8 * h;
        const bf16_t* bp = Bt + (size_t)r * 1024 + kq * 256 + 8 * h;
#pragma unroll 4
        for (int k0 = 0; k0 < 256; k0 += 16) {
            const bf16x8 a = *(const bf16x8*)(ap + k0);
#pragma unroll
            for (int nb = 0; nb < NBLK; ++nb) { const bf16x8 b = *(const bf16x8*)(bp + (size_t)nb * 32 * 1024 + k0);
                acc[nb] = __builtin_amdgcn_mfma_f32_32x32x16_bf16(a, b, acc[nb], 0, 0, 0); }
        }
        __syncthreads();
#pragma unroll
        for (int nb = 0; nb < NBLK; ++nb)
#pragma unroll
            for (int i = 0; i < 16; ++i) red[((w * NBLK + nb) * 16 + i) * 64 + lane] = acc[nb][i];
        __syncthreads();
        if (kq == 0) {
#pragma unroll
            for (int nb = 0; nb < NBLK; ++nb)
#pragma unroll
                for (int i = 0; i < 16; ++i) acc[nb][i] = (red[(((w + 0) * NBLK + nb) * 16 + i) * 64 + lane] + red[(((w + 1) * NBLK + nb) * 16 + i) * 64 + lane])
                                                         + (red[(((w + 2) * NBLK + nb) * 16 + i) * 64 + lane] + red[(((w + 3) * NBLK + nb) * 16 + i) * 64 + lane]);
#pragma unroll
            for (int i = 0; i < 16; ++i) { const int row = row0 + (i & 3) + 8 * (i >> 2) + 4 * h; const float rs = row_rstd(ssq, row);
                if (MODE == 0) { gg[(size_t)row * 32 + r] = acc[0][i] * rs; }
                else { const float x1 = acc[0][i] * rs, x2 = acc[NBLK - 1][i] * rs, c = ct[(size_t)row * 32 + r], sn = st[(size_t)row * 32 + r];
                    const unsigned wv = pk2(x1 * c - x2 * sn, x2 * c + x1 * sn); const int b = row >> 11, s = row & 2047;
#pragma unroll
                    for (int hd = 0; hd < 8; ++hd) *(unsigned*)(Kb + ((size_t)(b * 8 + hd) * SEQ + s) * 192 + 128 + 2 * r) = wv; } }
        }
    }
}
namespace att {
constexpr int DQ = 192, DV = 128, NW = 8, QBLK = 32, KVBLK = 64;
constexpr float SCALE = 0.07216878364870322f;
constexpr float THR = 8.f;
constexpr int SHM_V = KVBLK * DV * 2, SHM_K = KVBLK * DQ * 2, SHM_ATTN = 2 * SHM_V + 2 * SHM_K + NW * 64 * 4;
#define KSWZ(row, colB) ((row) * 384 + ((colB) ^ (((row) & 7) << 4)))
#define SBAR() __builtin_amdgcn_sched_barrier(0)
DI int crow(int r, int hi) { return (r & 3) + 8 * (r >> 2) + 4 * hi; }
DI void partialSM(f32x16& p0, f32x16& p1, float& m_reg, float& mn, float& alpha) {
    constexpr float C = SCALE * 1.4426950408889634f;
    float pmax = p0[0];
#pragma unroll
    for (int r = 1; r < 16; ++r) pmax = fmaxf(pmax, p0[r]);
#pragma unroll
    for (int r = 0; r < 16; ++r) pmax = fmaxf(pmax, p1[r]);
    { auto rr = __builtin_amdgcn_permlane32_swap(__float_as_uint(pmax), __float_as_uint(pmax), false, false);
      pmax = fmaxf(__uint_as_float(rr[0]), __uint_as_float(rr[1])); }
    if (__builtin_expect(__all(pmax - m_reg <= THR / SCALE), 1)) { mn = m_reg; alpha = 1.f; }
    else { mn = fmaxf(m_reg, pmax); alpha = __builtin_amdgcn_exp2f((m_reg - mn) * C); m_reg = mn; }
    const float mnC = -mn * C;
#pragma unroll
    for (int r = 0; r < 16; ++r) p0[r] = fmaf(p0[r], C, mnC);
#pragma unroll
    for (int r = 0; r < 16; ++r) p1[r] = fmaf(p1[r], C, mnC);
#pragma unroll
    for (int r = 0; r < 16; ++r) p0[r] = __builtin_amdgcn_exp2f(p0[r]);
}
DI void finishSM(f32x16& p0, f32x16& p1, float alpha, float& l_reg, bf16x8& pa0, bf16x8& pa1, bf16x8& pa2, bf16x8& pa3) {
#pragma unroll
    for (int r = 0; r < 16; ++r) p1[r] = __builtin_amdgcn_exp2f(p1[r]);
    float ps = 0;
#pragma unroll
    for (int r = 0; r < 16; ++r) ps += p0[r];
#pragma unroll
    for (int r = 0; r < 16; ++r) ps += p1[r];
    { auto rr = __builtin_amdgcn_permlane32_swap(__float_as_uint(ps), __float_as_uint(ps), false, false);
      ps = __uint_as_float(rr[0]) + __uint_as_float(rr[1]); }
    l_reg = l_reg * alpha + ps;
#define PK4(P, BASE, OUT) do { unsigned a0 = pk2(P[BASE + 0], P[BASE + 1]), a1 = pk2(P[BASE + 2], P[BASE + 3]);   \
    unsigned b0 = pk2(P[BASE + 4], P[BASE + 5]), b1 = pk2(P[BASE + 6], P[BASE + 7]);                              \
    auto r0 = __builtin_amdgcn_permlane32_swap(a0, b0, false, false); auto r1 = __builtin_amdgcn_permlane32_swap(a1, b1, false, false); \
    u32x4 w = {r0[0], r1[0], r0[1], r1[1]}; OUT = __builtin_bit_cast(bf16x8, w); } while (0)
    PK4(p0, 0, pa0); PK4(p0, 8, pa1); PK4(p1, 0, pa2); PK4(p1, 8, pa3);
#undef PK4
}
DI void qkt(f32x16& p0, f32x16& p1, const char* Ks, const int (&kb)[4], const bf16x8* qr) {
#pragma unroll
    for (int i = 0; i < 16; ++i) { p0[i] = 0.f; p1[i] = 0.f; }
#pragma unroll
    for (int d0 = 0; d0 < 12; ++d0) {
        const bf16x8 b0 = *reinterpret_cast<const bf16x8*>(Ks + kb[d0 & 3] + (d0 >> 2) * 128);
        const bf16x8 b1 = *reinterpret_cast<const bf16x8*>(Ks + kb[d0 & 3] + (d0 >> 2) * 128 + 32 * 384);
        p0 = __builtin_amdgcn_mfma_f32_32x32x16_bf16(b0, qr[d0], p0, 0, 0, 0);
        p1 = __builtin_amdgcn_mfma_f32_32x32x16_bf16(b1, qr[d0], p1, 0, 0, 0); }
}
DI int v_st(int k, int c) { const int kk = (k & ~0xC) | ((k & 4) << 1) | ((k & 8) >> 1); return ((kk >> 3) * 4 + (c >> 5)) * 512 + ((kk & 7) * 32 + (c & 31)) * 2; }
DI int v_rd_base(int lane) { return ((lane & 3) << 3) | (((lane >> 2) & 3) << 6) | (((lane >> 4) & 1) << 5) | (((lane >> 5) & 1) << 8); }
constexpr int v_rd_off(int d0, int ks, int half) { return d0 * 512 + ks * 4096 + half * 2048; }
template <int OFF> DI s16x4 tr_read(int vb) { s16x4 r; asm volatile("ds_read_b64_tr_b16 %0, %1 offset:%2" : "=&v"(r) : "v"(vb), "i"(OFF) : "memory"); return r; }
template <int D0> DI void pv_one(f32x16& od, int vb, bf16x8 pa0, bf16x8 pa1, bf16x8 pa2, bf16x8 pa3) {
    const s16x4 l0 = tr_read<v_rd_off(D0, 0, 0)>(vb), h0 = tr_read<v_rd_off(D0, 0, 1)>(vb), l1 = tr_read<v_rd_off(D0, 1, 0)>(vb), h1 = tr_read<v_rd_off(D0, 1, 1)>(vb);
    const s16x4 l2 = tr_read<v_rd_off(D0, 2, 0)>(vb), h2 = tr_read<v_rd_off(D0, 2, 1)>(vb), l3 = tr_read<v_rd_off(D0, 3, 0)>(vb), h3 = tr_read<v_rd_off(D0, 3, 1)>(vb);
    asm volatile("s_waitcnt lgkmcnt(0)" ::: "memory"); SBAR();
#define PKV(L, H) (bf16x8){L[0], L[1], L[2], L[3], H[0], H[1], H[2], H[3]}
    od = __builtin_amdgcn_mfma_f32_32x32x16_bf16(pa0, PKV(l0, h0), od, 0, 0, 0);
    od = __builtin_amdgcn_mfma_f32_32x32x16_bf16(pa1, PKV(l1, h1), od, 0, 0, 0);
    od = __builtin_amdgcn_mfma_f32_32x32x16_bf16(pa2, PKV(l2, h2), od, 0, 0, 0);
    od = __builtin_amdgcn_mfma_f32_32x32x16_bf16(pa3, PKV(l3, h3), od, 0, 0, 0);
#undef PKV
}
DI void pv_d0(f32x16* o, int vb, bf16x8 pa0, bf16x8 pa1, bf16x8 pa2, bf16x8 pa3) {
    pv_one<0>(o[0], vb, pa0, pa1, pa2, pa3); pv_one<1>(o[1], vb, pa0, pa1, pa2, pa3); pv_one<2>(o[2], vb, pa0, pa1, pa2, pa3); pv_one<3>(o[3], vb, pa0, pa1, pa2, pa3);
}
DI void attn_body(const bf16_t* __restrict__ Qb, const bf16_t* __restrict__ Kh, const bf16_t* __restrict__ Vh, bf16_t* __restrict__ Ob, int seq, char* lds) {
    const int tid = otid(), wid = tid >> 6, lane = tid & 63, r32 = lane & 31, hi = lane >> 5;
    char* V_lds = lds; char* K_lds = lds + 2 * SHM_V;
    float* ws = (float*)(lds + 2 * SHM_V + 2 * SHM_K) + wid * 64; float* li_l = ws; float* al_l = ws + 32;
    float m_reg = -1e30f, l_reg = 0; f32x16 o[4];
#pragma unroll
    for (int d = 0; d < 4; ++d)
#pragma unroll
        for (int r = 0; r < 16; ++r) o[d][r] = 0.f;
    bf16x8 qr[12];
    const bf16_t* Qw = Qb + (size_t)(wid * QBLK + r32) * DQ + hi * 8;
#pragma unroll
    for (int d0 = 0; d0 < 12; ++d0) qr[d0] = *(const bf16x8*)(Qw + d0 * 16);
    const int sr = tid >> 4, sc = (tid & 15) * 8, vst0 = v_st(sr, sc), vst1 = v_st(32 + sr, sc);
    int krow_[3], kcp_[3];
#pragma unroll
    for (int i = 0; i < 3; ++i) { const int pc = tid + 512 * i; krow_[i] = pc / 24; kcp_[i] = pc % 24; }
    const int vb0 = (int)(uintptr_t)V_lds + v_rd_base(lane);
    int kb[4];
#pragma unroll
    for (int b = 0; b < 4; ++b) kb[b] = r32 * 384 + ((b * 32 + hi * 16) ^ ((r32 & 7) << 4));
    bf16x8 vs0, vs1, ks0, ks1, ks2;
#define SLOAD(k0) do { vs0 = *(const bf16x8*)(Vh + (size_t)((k0) + sr) * DV + sc); vs1 = *(const bf16x8*)(Vh + (size_t)((k0) + 32 + sr) * DV + sc); \
    ks0 = *(const bf16x8*)(Kh + (size_t)((k0) + krow_[0]) * DQ + kcp_[0] * 8); ks1 = *(const bf16x8*)(Kh + (size_t)((k0) + krow_[1]) * DQ + kcp_[1] * 8); \
    ks2 = *(const bf16x8*)(Kh + (size_t)((k0) + krow_[2]) * DQ + kcp_[2] * 8); } while (0)
#define SWRITE(b) do { *(bf16x8*)(V_lds + (b) * SHM_V + vst0) = vs0; *(bf16x8*)(V_lds + (b) * SHM_V + vst1) = vs1; \
    *(bf16x8*)(K_lds + (b) * SHM_K + KSWZ(krow_[0], kcp_[0] * 16)) = ks0; *(bf16x8*)(K_lds + (b) * SHM_K + KSWZ(krow_[1], kcp_[1] * 16)) = ks1; \
    *(bf16x8*)(K_lds + (b) * SHM_K + KSWZ(krow_[2], kcp_[2] * 16)) = ks2; } while (0)
#define RESC(a) do { if (__any((a) < 1.f)) { if (hi == 0) al_l[r32] = (a); asm volatile("s_waitcnt lgkmcnt(0)" ::: "memory"); \
    _Pragma("unroll") for (int d = 0; d < 4; ++d) _Pragma("unroll") for (int r = 0; r < 16; ++r) o[d][r] *= al_l[crow(r, hi)]; } } while (0)
    f32x16 p0, p1; float mn, al; bf16x8 pa0, pa1, pa2, pa3; const int NT = seq / KVBLK;
    SLOAD(0); SWRITE(0); __syncthreads();
    for (int j = 0; j < NT; ++j) {
        const int bsel = j & 1;
        if (j + 1 < NT) SLOAD((j + 1) * KVBLK);
        SBAR(); qkt(p0, p1, K_lds + bsel * SHM_K, kb, qr);
        partialSM(p0, p1, m_reg, mn, al);
        RESC(al);
        finishSM(p0, p1, al, l_reg, pa0, pa1, pa2, pa3); SBAR();
        pv_d0(o, vb0 + bsel * SHM_V, pa0, pa1, pa2, pa3);
        if (j + 1 < NT) SWRITE(bsel ^ 1);
        __syncthreads();
    }
    if (hi == 0) li_l[r32] = l_reg; asm volatile("s_waitcnt lgkmcnt(0)" ::: "memory");
    float rli[16];
#pragma unroll
    for (int r = 0; r < 16; ++r) rli[r] = __builtin_amdgcn_rcpf(li_l[crow(r, hi)]);
    bf16_t* Ow = Ob + (size_t)(wid * QBLK) * 1024;
#pragma unroll
    for (int r = 0; r < 16; ++r) { const int orow = crow(r, hi);
#pragma unroll
        for (int d0 = 0; d0 < 4; ++d0) { const unsigned w = pk2(o[d0][r] * rli[r], 0.f); Ow[(size_t)orow * 1024 + d0 * 32 + r32] = (bf16_t)(w & 0xffffu); } }
    __syncthreads();
#undef SLOAD
#undef SWRITE
#undef RESC
}

}
namespace gla {
DI bf16x8 packregs(const f32x16& x, int s) { u32x4 w; w.x = pk2(x[8 * s], x[8 * s + 1]); w.y = pk2(x[8 * s + 2], x[8 * s + 3]); w.z = pk2(x[8 * s + 4], x[8 * s + 5]); w.w = pk2(x[8 * s + 6], x[8 * s + 7]); return __builtin_bit_cast(bf16x8, w); }
}

namespace gla2 {
constexpr int ITEM_BYTES = 49152 + 512;
constexpr int P_B = 0, P_GG = 32768, P_SEG = P_GG + 4096, P_W2 = P_SEG + 2048;
constexpr int S_Q = 0, S_K = 16384, S_KH = 32768, S_EEND = 49152, S_V = 49664, S_P = S_V + 32768, S_END = S_P + 9216;
static_assert(S_END <= LDS_XB_OFF && P_W2 + 17 * 128 * 4 <= LDS_XB_OFF, "GLA LDS");
DI void prep(const Params& p, int j, unsigned char* lds) {
    const int tid = otid(); unsigned char* ws = lws(p);
    const bf16_t* G = (const bf16_t*)(ws + WS_G); const float* gg = (const float*)(ws + WS_GG); unsigned char* img = ws + WS_GIMG;
    const float* w2 = IN(p, I_GLA_WG2) + (size_t)j * 2 * 16 * 512; const float* bg = IN(p, I_GLA_BG) + (size_t)j * 2 * 512;
    float* L_B = (float*)(lds + P_B); float* L_GG = (float*)(lds + P_GG); float* L_SEG = (float*)(lds + P_SEG); float* L_W2 = (float*)(lds + P_W2);
    const int gd = tid & 127, seg = tid >> 7;
    for (int grp = obid(); grp < 256; grp += ogrid()) {
        const int unit = grp >> 2, b = unit >> 3, hd = (unit >> 1) & 3, dir = unit & 1, c0 = (grp & 3) * 8;
        const bf16_t* Gb = G + (size_t)b * SEQ * 3072 + hd * 128; const float* ggb = gg + (size_t)b * SEQ * 32 + dir * 16;
        __syncthreads();
        for (int i = tid; i < 17 * 128; i += 512) { const int jj = i >> 7, d = i & 127; L_W2[i] = jj < 16 ? w2[(dir * 16 + jj) * 512 + hd * 128 + d] : bg[dir * 512 + hd * 128 + d]; }
        u32x4 qreg[2], kreg[2]; f32x4 greg;
#define G2_PREFETCH(c) do { \
        _Pragma("unroll") for (int i = 0; i < 2; ++i) { const int pc = tid + 512 * i, t = pc >> 4, c8 = (pc & 15) * 8; const int tok = dir ? (SEQ - 1 - (64 * (c) + t)) : (64 * (c) + t); \
            const unsigned go = (unsigned)tok * 3072u + (unsigned)c8; qreg[i] = *(const u32x4*)(Gb + go); kreg[i] = *(const u32x4*)(Gb + go + 512u); } \
        if (tid < 256) { const int t = tid >> 2, part = tid & 3; const int tok = dir ? (SEQ - 1 - (64 * (c) + t)) : (64 * (c) + t); greg = *(const f32x4*)(ggb + ((unsigned)tok * 32u + (unsigned)(part * 4))); } } while (0)
        G2_PREFETCH(c0);
        for (int it = 0; it < 8; ++it) { const int c = c0 + it;
            unsigned char* ib = img + (size_t)(unit * 32 + c) * ITEM_BYTES;
            if (tid < 256) *(f32x4*)(L_GG + (tid >> 2) * 16 + (tid & 3) * 4) = greg;
            __syncthreads();
            float bl[16]; float run = 0.f; float wcol[16];
#pragma unroll
            for (int jj = 0; jj < 16; ++jj) wcol[jj] = L_W2[jj * 128 + gd];
            const float bias = L_W2[16 * 128 + gd];
#pragma unroll
            for (int tt = 0; tt < 16; ++tt) { const f32x4* g4 = (const f32x4*)(L_GG + (16 * seg + tt) * 16); float z = bias;
#pragma unroll
                for (int q4 = 0; q4 < 4; ++q4) { const f32x4 gv = g4[q4]; z += gv[0] * wcol[4 * q4] + gv[1] * wcol[4 * q4 + 1] + gv[2] * wcol[4 * q4 + 2] + gv[3] * wcol[4 * q4 + 3]; }
                const float ls = fminf(z, 0.f) - __logf(1.0f + __expf(-fabsf(z))); run += ls * (1.0f / 16.0f); bl[tt] = run; }
            L_SEG[seg * 128 + gd] = run;
            __syncthreads();
            { float off = 0.f;
#pragma unroll
              for (int s2 = 0; s2 < 3; ++s2) off += (s2 < seg) ? L_SEG[s2 * 128 + gd] : 0.f;
#pragma unroll
              for (int tt = 0; tt < 16; ++tt) L_B[(16 * seg + tt) * 128 + gd] = bl[tt] + off;
              if (seg == 3) *(float*)(ib + 49152 + gd * 4) = __expf(off + run); }
            __syncthreads();
#pragma unroll
            for (int i = 0; i < 2; ++i) { const int pc = tid + 512 * i, t = pc >> 4, c8 = (pc & 15) * 8;
                const f32x4 b0 = *(const f32x4*)(L_B + t * 128 + c8), b1 = *(const f32x4*)(L_B + t * 128 + c8 + 4), e0 = *(const f32x4*)(L_B + 63 * 128 + c8), e1 = *(const f32x4*)(L_B + 63 * 128 + c8 + 4);
                float qv[8], kv[8], bb[8], be[8];
#pragma unroll
                for (int e = 0; e < 4; ++e) { qv[2 * e] = bflo(qreg[i][e]); qv[2 * e + 1] = bfhi(qreg[i][e]); kv[2 * e] = bflo(kreg[i][e]); kv[2 * e + 1] = bfhi(kreg[i][e]); bb[e] = b0[e]; bb[4 + e] = b1[e]; be[e] = e0[e]; be[4 + e] = e1[e]; }
                float qt[8], kt[8], kh[8];
#pragma unroll
                for (int e = 0; e < 8; ++e) { const float en = __expf(-bb[e]); qt[e] = qv[e] * __expf(bb[e]); kt[e] = kv[e] * en; kh[e] = kt[e] * __expf(be[e]); }
                const int g16 = c8 >> 4, a = (c8 >> 3) & 1; const int colLo = (16 * g16 + 4 * a) * 2, colHi = colLo + 16; const int sw = (t & 7) << 4;
                const int aLo = t * 256 + ((colLo & ~15) ^ sw) + (colLo & 15), aHi = t * 256 + ((colHi & ~15) ^ sw) + (colHi & 15);
                u32x2 wq0, wq1, wk0, wk1; wq0.x = pk2(qt[0], qt[1]); wq0.y = pk2(qt[2], qt[3]); wq1.x = pk2(qt[4], qt[5]); wq1.y = pk2(qt[6], qt[7]);
                wk0.x = pk2(kt[0], kt[1]); wk0.y = pk2(kt[2], kt[3]); wk1.x = pk2(kt[4], kt[5]); wk1.y = pk2(kt[6], kt[7]);
                *(u32x2*)(ib + aLo) = wq0; *(u32x2*)(ib + aHi) = wq1; *(u32x2*)(ib + 16384 + aLo) = wk0; *(u32x2*)(ib + 16384 + aHi) = wk1;
                u32x4 wh; wh.x = pk2(kh[0], kh[1]); wh.y = pk2(kh[2], kh[3]); wh.z = pk2(kh[4], kh[5]); wh.w = pk2(kh[6], kh[7]);
                *(u32x4*)(ib + 32768 + att::v_st(t, c8)) = wh; }
            if (it + 1 < 8) G2_PREFETCH(c + 1);
        }
#undef G2_PREFETCH
    }
}
template <int OFF> DI s16x4 trr(int vb) { s16x4 r; asm volatile("ds_read_b64_tr_b16 %0, %1 offset:%2" : "=&v"(r) : "v"(vb), "i"(OFF) : "memory"); return r; }
#define GPK(L, H) (bf16x8){L[0], L[1], L[2], L[3], H[0], H[1], H[2], H[3]}
DI void scan(const Params& p, int j, unsigned char* lds) {
    const int tid = otid(), lane = tid & 63, w = tid >> 6, r = lane & 31, h = lane >> 5; unsigned char* ws = lws(p);
    const bf16_t* G = (const bf16_t*)(ws + WS_G); const unsigned char* img = ws + WS_GIMG;
    float* L_EEND = (float*)(lds + S_EEND);
    unsigned char* L_Q = lds + S_Q; unsigned char* L_K = lds + S_K; unsigned char* L_V = lds + S_V; unsigned char* L_P = lds + S_P;
    const int vbase = (int)(uintptr_t)L_V + (w >> 2) * 16384 + (w & 3) * 512 + att::v_rd_base(lane);
    const int kbase = (int)(uintptr_t)(lds + S_KH) + att::v_rd_base(lane);
    for (int unit = obid(); unit < 64; unit += ogrid()) {
        const int b = unit >> 3, hd = (unit >> 1) & 3, dir = unit & 1;
        bf16_t* ob = (bf16_t*)(ws + (dir ? WS_OBW : WS_OFW)) + (size_t)b * SEQ * 1024 + hd * 256;
        const bf16_t* Gv = G + (size_t)b * SEQ * 3072 + 1024 + hd * 256;
        f32x16 S[4];
#pragma unroll
        for (int kd = 0; kd < 4; ++kd)
#pragma unroll
            for (int i = 0; i < 16; ++i) S[kd][i] = 0.f;
        u32x4 ireg[6], vreg[4], ereg;
#define G2_LOAD(c) do { const unsigned char* ib = img + (size_t)(unit * 32 + (c)) * ITEM_BYTES; \
        _Pragma("unroll") for (int i = 0; i < 6; ++i) ireg[i] = *(const u32x4*)(ib + (tid + 512 * i) * 16); \
        if (tid < 32) ereg = *(const u32x4*)(ib + 49152 + tid * 16); \
        _Pragma("unroll") for (int i = 0; i < 4; ++i) { const int pc = tid + 512 * i, t = pc >> 5, c8 = (pc & 31) * 8; const int tok = dir ? (SEQ - 1 - (64 * (c) + t)) : (64 * (c) + t); \
            vreg[i] = *(const u32x4*)(Gv + ((unsigned)tok * 3072u + (unsigned)c8)); } } while (0)
        G2_LOAD(0);
        for (int c = 0; c < 32; ++c) {
            __syncthreads();
#pragma unroll
            for (int i = 0; i < 6; ++i) *(u32x4*)(lds + (tid + 512 * i) * 16) = ireg[i];
            if (tid < 32) *(u32x4*)(lds + S_EEND + tid * 16) = ereg;
#pragma unroll
            for (int i = 0; i < 4; ++i) { const int pc = tid + 512 * i, t = pc >> 5, c8 = (pc & 31) * 8; *(u32x4*)(L_V + (c8 >> 7) * 16384 + att::v_st(t, c8 & 127)) = vreg[i]; }
            if (c + 1 < 32) G2_LOAD(c + 1);
            __syncthreads();
            if (w < 3) { const int mt = (w + 1) >> 1, nt = w == 2 ? 1 : 0; f32x16 sc;
#pragma unroll
                for (int i = 0; i < 16; ++i) sc[i] = 0.f;
                const int rk = 32 * nt + r, rq = 32 * mt + r;
#pragma unroll
                for (int ks = 0; ks < 8; ++ks) { const int cb = 32 * ks + 16 * h;
                    const bf16x8 ka = *(const bf16x8*)(L_K + rk * 256 + (cb ^ ((rk & 7) << 4))); const bf16x8 qb = *(const bf16x8*)(L_Q + rq * 256 + (cb ^ ((rq & 7) << 4)));
                    sc = __builtin_amdgcn_mfma_f32_32x32x16_bf16(ka, qb, sc, 0, 0, 0); }
                if (w != 1) {
#pragma unroll
                    for (int i = 0; i < 16; ++i) { const int s = (i & 3) + 8 * (i >> 2) + 4 * h; const bool keep = dir ? (s < r) : (s <= r); sc[i] = keep ? sc[i] : 0.f; } }
#pragma unroll
                for (int g = 0; g < 4; ++g) { u32x2 wv; wv.x = pk2(sc[4 * g], sc[4 * g + 1]); wv.y = pk2(sc[4 * g + 2], sc[4 * g + 3]); *(u32x2*)(L_P + rq * 144 + (32 * nt + 8 * g + 4 * h) * 2) = wv; }
            } else if (w == 3) {
#pragma unroll
                for (int g = 0; g < 4; ++g) { u32x2 z2; z2.x = 0u; z2.y = 0u; *(u32x2*)(L_P + r * 144 + (32 + 8 * g + 4 * h) * 2) = z2; }
            }
            f32x16 oacc[2];
#pragma unroll
            for (int mt = 0; mt < 2; ++mt)
#pragma unroll
                for (int i = 0; i < 16; ++i) oacc[mt][i] = 0.f;
#pragma unroll
            for (int ks = 0; ks < 8; ++ks) { const bf16x8 sf = gla::packregs(S[ks >> 1], ks & 1); const int cb = 32 * ks + 16 * h;
#pragma unroll
                for (int mt = 0; mt < 2; ++mt) { const int rq = 32 * mt + r; const bf16x8 qa = *(const bf16x8*)(L_Q + rq * 256 + (cb ^ ((rq & 7) << 4)));
                    oacc[mt] = __builtin_amdgcn_mfma_f32_32x32x16_bf16(qa, sf, oacc[mt], 0, 0, 0); } }
            __syncthreads();
            bf16x8 vf[4];
            { const s16x4 l0 = trr<0>(vbase), h0 = trr<2048>(vbase), l1 = trr<4096>(vbase), h1 = trr<4096 + 2048>(vbase), l2 = trr<8192>(vbase), h2 = trr<8192 + 2048>(vbase), l3 = trr<12288>(vbase), h3 = trr<12288 + 2048>(vbase);
              asm volatile("s_waitcnt lgkmcnt(0)" ::: "memory"); __builtin_amdgcn_sched_barrier(0);
              vf[0] = GPK(l0, h0); vf[1] = GPK(l1, h1); vf[2] = GPK(l2, h2); vf[3] = GPK(l3, h3); }
#pragma unroll
            for (int mt = 0; mt < 2; ++mt)
#pragma unroll
                for (int ks = 0; ks < 4; ++ks) { const bf16x8 pa = *(const bf16x8*)(L_P + (32 * mt + r) * 144 + (16 * ks + 8 * h) * 2);
                    oacc[mt] = __builtin_amdgcn_mfma_f32_32x32x16_bf16(pa, vf[ks], oacc[mt], 0, 0, 0); }
#pragma unroll
            for (int mt = 0; mt < 2; ++mt)
#pragma unroll
                for (int i = 0; i < 16; ++i) { const int t = 32 * mt + (i & 3) + 8 * (i >> 2) + 4 * h; const int tok = dir ? (SEQ - 1 - (64 * c + t)) : (64 * c + t);
                    ob[(unsigned)tok * 1024u + (unsigned)(32 * w + r)] = (bf16_t)(pk2(oacc[mt][i], 0.f) & 0xffffu); }
#define G2_STATE(KD) do { \
            const s16x4 l0 = trr<(KD) * 512>(kbase), h0 = trr<(KD) * 512 + 2048>(kbase), l1 = trr<(KD) * 512 + 4096>(kbase), h1 = trr<(KD) * 512 + 4096 + 2048>(kbase), \
                        l2 = trr<(KD) * 512 + 8192>(kbase), h2 = trr<(KD) * 512 + 8192 + 2048>(kbase), l3 = trr<(KD) * 512 + 12288>(kbase), h3 = trr<(KD) * 512 + 12288 + 2048>(kbase); \
            asm volatile("s_waitcnt lgkmcnt(0)" ::: "memory"); __builtin_amdgcn_sched_barrier(0); \
            _Pragma("unroll") for (int g = 0; g < 4; ++g) { const f32x4 e4 = *(const f32x4*)(L_EEND + 32 * (KD) + 8 * g + 4 * h); \
                S[KD][4 * g] *= e4[0]; S[KD][4 * g + 1] *= e4[1]; S[KD][4 * g + 2] *= e4[2]; S[KD][4 * g + 3] *= e4[3]; } \
            S[KD] = __builtin_amdgcn_mfma_f32_32x32x16_bf16(GPK(l0, h0), vf[0], S[KD], 0, 0, 0); S[KD] = __builtin_amdgcn_mfma_f32_32x32x16_bf16(GPK(l1, h1), vf[1], S[KD], 0, 0, 0); \
            S[KD] = __builtin_amdgcn_mfma_f32_32x32x16_bf16(GPK(l2, h2), vf[2], S[KD], 0, 0, 0); S[KD] = __builtin_amdgcn_mfma_f32_32x32x16_bf16(GPK(l3, h3), vf[3], S[KD], 0, 0, 0); } while (0)
            G2_STATE(0); G2_STATE(1); G2_STATE(2); G2_STATE(3);
#undef G2_STATE
        }
        __syncthreads();
#undef G2_LOAD
    }
}
#undef GPK
}
DI void gla_gated_norm(const Params& p, int j) {
    const int tid = otid(), lane = tid & 63, l = lane & 31; unsigned char* ws = lws(p);
    const bf16_t* ofw = (const bf16_t*)(ws + WS_OFW); const bf16_t* obw = (const bf16_t*)(ws + WS_OBW); const bf16_t* G = (const bf16_t*)(ws + WS_G); bf16_t* on = (bf16_t*)(ws + WS_ON);
    const float* hn = IN(p, I_GLA_HN) + j * 256;
    const int wv = obid() * 8 + (tid >> 6), nwv = ogrid() * 8;
    float g8[8];
#pragma unroll
    for (int e = 0; e < 8; ++e) g8[e] = hn[l * 8 + e];
    for (int pr = wv; pr < MT * 2; pr += nwv) {
        const int rh = pr * 2 + (lane >> 5), row = rh >> 2, h = rh & 3; const size_t off = (size_t)row * 1024 + h * 256 + l * 8;
        const u32x4 a = *(const u32x4*)(ofw + off), bq = *(const u32x4*)(obw + off), rr = *(const u32x4*)(G + (size_t)row * 3072 + 2048 + h * 256 + l * 8);
        float o[8], rv[8];
#pragma unroll
        for (int e = 0; e < 4; ++e) { o[2 * e] = bflo(a[e]) + bflo(bq[e]); o[2 * e + 1] = bfhi(a[e]) + bfhi(bq[e]); rv[2 * e] = bflo(rr[e]); rv[2 * e + 1] = bfhi(rr[e]); }
        float ss = 0.f;
#pragma unroll
        for (int e = 0; e < 8; ++e) ss += o[e] * o[e];
#pragma unroll
        for (int s = 16; s >= 1; s >>= 1) ss += __shfl_xor(ss, s);
        const float rs = rsqrtf(ss * (1.0f / 256.0f) + EPS);
        float y[8];
#pragma unroll
        for (int e = 0; e < 8; ++e) y[e] = o[e] * rs * g8[e] * silu_f(rv[e]);
        u32x4 w; w.x = pk2(y[0], y[1]); w.y = pk2(y[2], y[3]); w.z = pk2(y[4], y[5]); w.w = pk2(y[6], y[7]);
        *(u32x4*)(on + off) = w;
    }
}
DI void final_norm(const Params& p) {
    const int tid = otid(), lane = tid & 63; unsigned char* ws = lws(p);
    const bf16_t* xb = (const bf16_t*)(ws + WS_XB); const float* ssq = (const float*)(ws + WS_SSQ) + (size_t)12 * MT * 16; const float* g = IN(p, I_FINAL_NORM);
    const int wv = obid() * 8 + (tid >> 6), nwv = ogrid() * 8;
    for (int row = wv; row < MT; row += nwv) { const float rs = row_rstd(ssq, row);
#pragma unroll
        for (int i = 0; i < 2; ++i) { const u32x4 xi = ((const u32x4*)(xb + (size_t)row * 1024))[lane + 64 * i];
            const f32x4 g0 = ((const f32x4*)g)[2 * (lane + 64 * i)], g1 = ((const f32x4*)g)[2 * (lane + 64 * i) + 1]; f32x4 o0, o1;
            o0[0] = bflo(xi[0]) * rs * g0[0]; o0[1] = bfhi(xi[0]) * rs * g0[1]; o0[2] = bflo(xi[1]) * rs * g0[2]; o0[3] = bfhi(xi[1]) * rs * g0[3];
            o1[0] = bflo(xi[2]) * rs * g1[0]; o1[1] = bfhi(xi[2]) * rs * g1[1]; o1[2] = bflo(xi[3]) * rs * g1[2]; o1[3] = bfhi(xi[3]) * rs * g1[3];
            float* op = lout(p) + (size_t)row * 1024 + 8 * (lane + 64 * i); *(f32x4*)op = o0; *(f32x4*)(op + 4) = o1; } }
}

constexpr int NPH = 38;
DI void run_phase(const Params& p, int ph, unsigned char* shm, float ascale) {
    unsigned char* ws = lws(p); LAS unsigned char* lds = (LAS unsigned char*)shm;
    bf16_t* xb = (bf16_t*)(ws + WS_XB); bf16_t* act = (bf16_t*)(ws + WS_ACT); float* ssq = (float*)(ws + WS_SSQ);
    if (ph == 0) { prep_phase(p); return; }
    if (ph == NPH - 1) { final_norm(p); return; }
    const int li = (ph - 1) / 9, sub = (ph - 1) % 9, j = li >> 1; const bool mla = li & 1;
    if (sub == 0 || sub == 7) { const int s = sub == 7; EpiGateUp E; E.act = act; E.rt = fill_rstd(shm, 5632, ssq + (size_t)(3 * li + (s ? 2 : 0)) * MT * 16, 0, 16, 1.0f / 1024.0f);
        run_gemm(lds, xb, (const bf16_t*)(ws + WS_WGU + (size_t)(li * 2 + s) * SZ_WGU), 5632, 1024, E); return; }
    if (sub == 1 || sub == 8) { const int s = sub == 8; EpiResid E; E.xb = xb; E.ssq_out = ssq + (size_t)(3 * li + (s ? 3 : 1)) * MT * 16; E.alpha = 0.5f * ascale;
        run_gemm(lds, act, (const bf16_t*)(ws + WS_WD + (size_t)(li * 2 + s) * SZ_WD), 1024, 2816, E); return; }
    const float* ssq_mix = ssq + (size_t)(3 * li + 1) * MT * 16;
    if (!mla) {
        if (sub == 2) { skinny_gemm<1, 0>(xb, (const bf16_t*)(ws + WS_GWG + (size_t)j * 32 * 1024 * 2), ssq_mix, (float*)(ws + WS_GG), nullptr, nullptr, nullptr, shm);
            __syncthreads();
            EpiGlaIn E; E.G = (bf16_t*)(ws + WS_G); E.rt = fill_rstd(shm, 3072, ssq_mix, 0, 16, 1.0f / 1024.0f); run_gemm(lds, xb, (const bf16_t*)(ws + WS_GWIN + (size_t)j * 3072 * 1024 * 2), 3072, 1024, E); return; }
        if (sub == 3) { gla2::prep(p, j, shm); return; }
        if (sub == 4) { gla2::scan(p, j, shm);
            if (ogrid() > 64 && obid() >= 64) cvt_weights(p, j == 0 ? CVT_S0 : CVT_S2, 64, ogrid() - 64);
            return; }
        if (sub == 5) { gla_gated_norm(p, j); return; }
        if (sub == 6) { EpiResid E; E.xb = xb; E.ssq_out = ssq + (size_t)(3 * li + 2) * MT * 16; E.alpha = 1.0f * ascale;
            run_gemm(lds, (const bf16_t*)(ws + WS_ON), (const bf16_t*)(ws + WS_GWOUT + (size_t)j * 1024 * 1024 * 2), 1024, 1024, E); return; }
    } else {
        float* ssq_qkv = (float*)(ws + WS_SSQQ) + (size_t)j * MT * 16;
        const float* ct = (const float*)(ws + WS_COS); const float* st = (const float*)(ws + WS_SIN);
        if (sub == 2) { skinny_gemm<2, 1>(xb, (const bf16_t*)(ws + WS_MWKPE + (size_t)j * 64 * 1024 * 2), ssq_mix, nullptr, (bf16_t*)(ws + WS_KB), ct, st, shm);
            __syncthreads();
            EpiMlaIn E; E.cq = (bf16_t*)(ws + WS_CQ); E.ckv = (bf16_t*)(ws + WS_CKV); E.rt = fill_rstd(shm, 1024, ssq_mix, 0, 16, 1.0f / 1024.0f); E.ssq_qkv = ssq_qkv;
            run_gemm(lds, xb, (const bf16_t*)(ws + WS_MWIN + (size_t)j * 1024 * 1024 * 2), 1024, 1024, E); return; }
        if (sub == 3) { { EpiUq E; E.Q = (bf16_t*)(ws + WS_Q); E.rt = fill_rstd(shm, 1536, ssq_qkv, 0, 12, 1.0f / 768.0f); E.ct = ct; E.st = st;
              run_gemm(lds, (const bf16_t*)(ws + WS_CQ), (const bf16_t*)(ws + WS_MWUQ + (size_t)j * 1536 * 768 * 2), 1536, 768, E); }
            __syncthreads();
            { EpiUkv E; E.Kb = (bf16_t*)(ws + WS_KB); E.Vb = (bf16_t*)(ws + WS_VB); E.rt = fill_rstd(shm, 2048, ssq_qkv, 12, 4, 1.0f / 256.0f);
              run_gemm(lds, (const bf16_t*)(ws + WS_CKV), (const bf16_t*)(ws + WS_MWUKV + (size_t)j * 2048 * 256 * 2), 2048, 256, E); }
            return; }
        if (sub == 4) { const bf16_t* Q = (const bf16_t*)(ws + WS_Q); const bf16_t* Kb = (const bf16_t*)(ws + WS_KB); const bf16_t* Vb = (const bf16_t*)(ws + WS_VB); bf16_t* O = (bf16_t*)(ws + WS_O);
            for (int U = obid(); U < 512; U += ogrid()) { const int bh = (U & 7) + 8 * (U >> 6), qb = (U >> 3) & 7, b = bh >> 3, h = bh & 7;
                att::attn_body(Q + ((size_t)bh * SEQ + qb * 256) * 192, Kb + (size_t)bh * SEQ * 192, Vb + (size_t)bh * SEQ * 128, O + ((size_t)b * SEQ + qb * 256) * 1024 + h * 128, SEQ, (char*)shm); }
            return; }
        if (sub == 5) { EpiResid E; E.xb = xb; E.ssq_out = ssq + (size_t)(3 * li + 2) * MT * 16; E.alpha = 1.0f * ascale;
            run_gemm(lds, (const bf16_t*)(ws + WS_O), (const bf16_t*)(ws + WS_MWOUT + (size_t)j * 1024 * 1024 * 2), 1024, 1024, E); return; }
    }
}
DI bool phase_empty(int ph) { if (ph == 0 || ph == NPH - 1) return false; const int li = (ph - 1) / 9, sub = (ph - 1) % 9; return (li & 1) && sub == 6; }
__global__ void __launch_bounds__(512, 2) mega_fwd(Params p) {
    extern __shared__ __attribute__((aligned(16))) unsigned char shm[];
    cg::grid_group grid = cg::this_grid();
    volatile LAS unsigned* xst = (volatile LAS unsigned*)((LAS unsigned char*)shm + LDS_XB_OFF);
    if (threadIdx.x < 4) xst[threadIdx.x] = 0u;
    __syncthreads();
    const XcdBarrier xb = xcd_barrier_post((unsigned*)(p.ws + WS_BAR), xst);
#ifndef PROBE_MASK
#define PROBE_MASK 0ull
#endif
#ifndef PROBE_REPS
#define PROBE_REPS 1
#endif
#ifdef PROBE_SYNCS
    for (int i = 0; i < PROBE_SYNCS; ++i) xcd_barrier(xb);
#endif
    grid.sync();
    for (int ph = p.ph_lo; ph < p.ph_hi; ++ph) {
        if (phase_empty(ph)) continue;
        const int reps = ((PROBE_MASK >> ph) & 1ull) ? 1 + PROBE_REPS : 1;
        for (int rep = 0; rep < reps; ++rep) {
            run_phase(p, ph, shm, rep ? 0.f : 1.f);
            if (ph + 1 < p.ph_hi || rep + 1 < reps) xcd_barrier(xb);
        }
    }
}

extern "C" void kernel_launch(void* const* d_in, const int* in_sizes, int n_in, void* d_out, int out_size, void* d_ws, size_t ws_size, hipStream_t stream) {
    static int grid = 0;
    if (grid == 0) {
        if (n_in != 18 || out_size != MT * DM || ws_size < WS_END) { fprintf(stderr, "kernel_launch: unexpected shapes (n_in %d out %d ws %zu need %zu)\n", n_in, out_size, ws_size, (size_t)WS_END); grid = -1; return; }
        int dev = 0, cus = 0, per_cu = 0;
        if (hipGetDevice(&dev) != hipSuccess || hipDeviceGetAttribute(&cus, hipDeviceAttributeMultiprocessorCount, dev) != hipSuccess) { grid = -1; return; }
        if (hipFuncSetAttribute((const void*)mega_fwd, hipFuncAttributeMaxDynamicSharedMemorySize, LDS_BYTES) != hipSuccess) { fprintf(stderr, "kernel_launch: hipFuncSetAttribute failed\n"); grid = -1; return; }
        if (hipOccupancyMaxActiveBlocksPerMultiprocessor(&per_cu, (const void*)mega_fwd, 512, LDS_BYTES) != hipSuccess || per_cu < 1) { fprintf(stderr, "kernel_launch: occupancy query says %d\n", per_cu); per_cu = 1; }
        (void)hipGetLastError();
        grid = cus;
    }
    if (grid < 0) return;
    if (hipMemsetAsync((char*)d_ws + WS_BAR, 0, WS_BAR_BYTES, stream) != hipSuccess) { fprintf(stderr, "kernel_launch: memset of the barrier words failed\n"); return; }
    Params p{};
    for (int i = 0; i < 18; ++i) p.in[i] = (const float*)d_in[i];
    p.out = (float*)d_out; p.ws = (unsigned char*)d_ws;
    for (int i = 0; i < 32; ++i) p.inv_freq[i] = 1.0f / powf(10000.0f, (float)(2 * i) / 64.0f);
#ifndef MK_PER_PHASE
#define MK_PER_PHASE 0
#endif
    const int nl = MK_PER_PHASE ? NPH : 1;
    for (int li = 0; li < nl; ++li) {
        p.ph_lo = MK_PER_PHASE ? li : 0; p.ph_hi = MK_PER_PHASE ? li + 1 : NPH;
        void* args[] = {&p};
        hipError_t e = hipLaunchCooperativeKernel((const void*)mega_fwd, dim3(grid), dim3(512), args, LDS_BYTES, stream);
        if (e != hipSuccess) { fprintf(stderr, "kernel_launch: cooperative launch failed: %s (grid %d)\n", hipGetErrorString(e), grid); break; }
    }
}
```

```cpp
#include <hip/hip_runtime.h>
#include <hip/hip_cooperative_groups.h>
#include <cstdio>
#include <cmath>
namespace cg = cooperative_groups;
__device__ __forceinline__ int otid() { int t = threadIdx.x; asm volatile("" : "+v"(t)); return t; }
__device__ __forceinline__ int obid() { int b = blockIdx.x; asm volatile("" : "+s"(b)); return b; }
__device__ __forceinline__ int ogrid() { int g = gridDim.x; asm volatile("" : "+s"(g)); return g; }
namespace pg8 {
#define PG8_LAS __attribute__((address_space(3)))
typedef unsigned short bf16_t;
typedef short bf16x8 __attribute__((ext_vector_type(8)));
typedef float f32x4 __attribute__((ext_vector_type(4)));
typedef unsigned u32x4 __attribute__((ext_vector_type(4)));
constexpr int BM = 256, BK = 64, HALF = 128, HTB = HALF * BK * 2  , STAGE_BYTES = 8 * HTB, NXCD = 8, WGM = 8;

__host__ __device__ __forceinline__ int lds_byte(int r, int c) { const int st = (r >> 4) * 2 + (c >> 5), rr = r & 15, cc = c & 31, ob = rr * 64 + cc * 2; return st * 1024 + (ob ^ (((ob >> 9) & 1) << 5)); }
__host__ __device__ __forceinline__ void stage_rc(int b, int& R, int& C) { const int st = b / 1024, sb = b % 1024, swz = sb ^ (((sb >> 9) & 1) << 5); R = (st >> 1) * 16 + swz / 64; C = (st & 1) * 32 + (swz % 64) / 2; }
__host__ __device__ __forceinline__ int perm32(int rho) { const int n = rho >> 4, i = rho & 15; return 8 * (i >> 2) + 4 * n + (i & 3); }

struct Unit { int pm, pn; };
struct Gemm { const bf16_t* A; const bf16_t* Bt; int M, N, K; };

struct StaticOrder {
    int nM, nN, nwg, G, c;
    __host__ __device__ void init(int M, int N, int G_, int c_) { nM = M / BM; nN = N / BM; nwg = nM * nN; G = G_; c = c_; uneven = 0; }
    int uneven;
    __host__ __device__ bool next(int i, Unit& u) const {
        long L;
        if (uneven) { const int H = G / 2; if (c < H) { if (i > 0) return false; L = c; } else { if (i > 2) return false; L = H + (long)(c - H) * 3 + i; } }
        else { L = (long)i * G + c; if (L >= nwg) return false; }
        int wgid = (int)L; { const int q = nwg / NXCD, r = nwg % NXCD, xcd = wgid % NXCD, off = wgid / NXCD; wgid = (xcd < r ? xcd * (q + 1) : r * (q + 1) + (xcd - r) * q) + off; }
        const int nig = WGM * nN, gid = wgid / nig, fm = gid * WGM, gsz = (nM - fm) < WGM ? (nM - fm) : WGM;
        u.pm = fm + ((wgid % nig) % gsz); u.pn = (wgid % nig) / gsz; return true;
    }
    __device__ __forceinline__ void a_ready(const Unit&) const {}
    __device__ __forceinline__ void done(const Unit&) const {}
};
template <class Epi, class Sched, bool STAMP = false>
__device__ __forceinline__ void gemm_phase(PG8_LAS unsigned char* lds, const Gemm g, const Sched& S, const Epi& E, unsigned long long* stamps) {
    const int tid = otid(), wid = __builtin_amdgcn_readfirstlane(tid >> 6), lane = tid & 63, wr = wid >> 2, wc = wid & 3, fr = lane & 15, fq = lane >> 4;
    const int K = g.K, nt = K / BK;
    int ts_lo = 0, ts_hi = 0, nts = 0; const unsigned long long rt_entry = STAMP ? (unsigned long long)wall_clock64() : 0ull;
#define PG8_STAMP() do { if (STAMP && wid == 0 && nts < 64) { const unsigned long long _c = (unsigned long long)clock64(); \
        ts_lo = (lane == nts) ? (int)(unsigned)_c : ts_lo; ts_hi = (lane == nts) ? (int)(unsigned)(_c >> 32) : ts_hi; ++nts; } } while (0)
    PG8_STAMP();
    unsigned voffA[2], voffB[2];
#pragma unroll
    for (int i = 0; i < 2; ++i) { int R, C; stage_rc(tid * 16 + i * 8192, R, C); const int Rb = Epi::PERM ? ((R & ~31) + perm32(R & 31)) : R;
        voffA[i] = (unsigned)(R * K + C) * 2u; voffB[i] = (unsigned)(Rb * K + C) * 2u; }
    const size_t kstep = (size_t)(BK * 2);
    const size_t hstep = (size_t)HALF * K * 2;
    const size_t tstep = 2 * hstep;
    const unsigned ldsw = (unsigned)wid * 1024u;
    const int aoff = lds_byte(wr * 64 + fr, fq * 8), boff = lds_byte(wc * 32 + fr, fq * 8);
#define PG8_SA(b, h) (((b) * 2 + (h)) * HTB)
#define PG8_SB(b, h) ((4 + (b) * 2 + (h)) * HTB)
#define PG8_STAGE(bufoff, gbase, voff) do { _Pragma("unroll") for (int _i = 0; _i < 2; ++_i) \
        __builtin_amdgcn_global_load_lds((const unsigned*)((const char*)(gbase) + (voff)[_i]), (PG8_LAS unsigned*)(lds + (bufoff) + ldsw + _i * 8192), 16, 0, 0); } while (0)
#define PG8_LDA(dst, b, h) do { _Pragma("unroll") for (int m = 0; m < 4; ++m) _Pragma("unroll") for (int k = 0; k < 2; ++k) dst[m][k] = *(const PG8_LAS bf16x8*)(lds + PG8_SA(b, h) + aoff + m * 2048 + k * 1024); } while (0)
#define PG8_LDB(dst, b, h) do { _Pragma("unroll") for (int n = 0; n < 2; ++n) _Pragma("unroll") for (int k = 0; k < 2; ++k) dst[n][k] = *(const PG8_LAS bf16x8*)(lds + PG8_SB(b, h) + boff + n * 2048 + k * 1024); } while (0)
#define PG8_MMA(ai, bj, At, Bt) do { __builtin_amdgcn_s_setprio(1); _Pragma("unroll") for (int m = 0; m < 4; ++m) _Pragma("unroll") for (int n = 0; n < 2; ++n) _Pragma("unroll") for (int k = 0; k < 2; ++k) \
        acc[ai][bj][m][n] = __builtin_amdgcn_mfma_f32_16x16x32_bf16(Bt[n][k], At[m][k], acc[ai][bj][m][n], 0, 0, 0); __builtin_amdgcn_s_setprio(0); } while (0)
#define PG8_WAIT_V(n) asm volatile("s_waitcnt vmcnt(" #n ")" ::: "memory")
#define PG8_WAIT_L(n) asm volatile("s_waitcnt lgkmcnt(" #n ")" ::: "memory")
#define PG8_BAR __builtin_amdgcn_s_barrier()
#define PG8_SCHED __builtin_amdgcn_sched_barrier(0)
    Unit cur, nxt; int ui = 0;
    if (!S.next(0, cur)) return;
    f32x4 acc[2][2][4][2];
#pragma unroll
    for (int a = 0; a < 2; ++a)
#pragma unroll
        for (int b = 0; b < 2; ++b)
#pragma unroll
            for (int m = 0; m < 4; ++m)
#pragma unroll
                for (int n = 0; n < 2; ++n) acc[a][b][m][n] = (f32x4){0.f, 0.f, 0.f, 0.f};
    bf16x8 At[4][2], B0[2][2], B1[2][2];
    const char* cA = (const char*)g.A + (size_t)cur.pm * tstep; const char* cB = (const char*)g.Bt + (size_t)cur.pn * tstep;
    S.a_ready(cur);
    PG8_STAGE(PG8_SB(0, 0), cB, voffB); PG8_STAGE(PG8_SA(0, 0), cA, voffA); PG8_STAGE(PG8_SB(0, 1), cB + hstep, voffB); PG8_STAGE(PG8_SA(0, 1), cA + hstep, voffA);
    if (wr == 1) PG8_BAR;
    PG8_WAIT_V(4); PG8_BAR;
    PG8_STAGE(PG8_SB(1, 0), cB + kstep, voffB); PG8_STAGE(PG8_SA(1, 0), cA + kstep, voffA); PG8_STAGE(PG8_SB(1, 1), cB + hstep + kstep, voffB);
    PG8_WAIT_V(6); PG8_BAR;
    PG8_STAMP();
    for (;;) {
        const bool has_next = S.next(ui + 1, nxt);
        const char* nA = has_next ? (const char*)g.A + (size_t)nxt.pm * tstep : cA; const char* nB = has_next ? (const char*)g.Bt + (size_t)nxt.pn * tstep : cB;
        for (int t = 0; t < nt; t += 2) {
            const bool last = (t == nt - 2);
            const char* a1 = cA + (size_t)(t + 1) * kstep;
            const char* a2 = last ? nA : cA + (size_t)(t + 2) * kstep; const char* b2 = last ? nB : cB + (size_t)(t + 2) * kstep;
            const char* a3 = a2 + kstep; const char* b3 = b2 + kstep;
            if (last && has_next) S.a_ready(nxt);
            PG8_LDB(B0, 0, 0); PG8_SCHED; PG8_LDA(At, 0, 0); PG8_STAGE(PG8_SA(1, 1), a1 + hstep, voffA);
            PG8_WAIT_L(8); PG8_BAR; PG8_WAIT_L(0); PG8_MMA(0, 0, At, B0); PG8_BAR; PG8_SCHED;
            PG8_LDB(B1, 0, 1); PG8_STAGE(PG8_SB(0, 0), b2, voffB);
            PG8_BAR; PG8_WAIT_L(0); PG8_MMA(0, 1, At, B1); PG8_BAR;
            PG8_LDA(At, 0, 1); PG8_STAGE(PG8_SA(0, 0), a2, voffA);
            PG8_BAR; PG8_WAIT_L(0); PG8_MMA(1, 0, At, B0); PG8_BAR; PG8_SCHED;
            PG8_STAGE(PG8_SB(0, 1), b2 + hstep, voffB);
            PG8_WAIT_V(6); PG8_BAR; PG8_MMA(1, 1, At, B1); PG8_BAR;
            PG8_LDB(B0, 1, 0); PG8_SCHED; PG8_LDA(At, 1, 0); PG8_STAGE(PG8_SA(0, 1), a2 + hstep, voffA);
            PG8_WAIT_L(8); PG8_BAR; PG8_WAIT_L(0); PG8_MMA(0, 0, At, B0); PG8_BAR; PG8_SCHED;
            PG8_LDB(B1, 1, 1); PG8_STAGE(PG8_SB(1, 0), b3, voffB);
            PG8_BAR; PG8_WAIT_L(0); PG8_MMA(0, 1, At, B1); PG8_BAR;
            PG8_LDA(At, 1, 1); PG8_STAGE(PG8_SA(1, 0), a3, voffA);
            PG8_BAR; PG8_WAIT_L(0); PG8_MMA(1, 0, At, B0); PG8_BAR; PG8_SCHED;
            PG8_STAGE(PG8_SB(1, 1), b3 + hstep, voffB);
            PG8_WAIT_V(6); PG8_BAR; PG8_MMA(1, 1, At, B1); PG8_BAR;
        }
        PG8_STAMP();
        if constexpr (!Epi::AFTER_DRAIN) { E(acc, cur, wr, wc, fr, fq); S.done(cur); }
        PG8_STAMP();
        if (!has_next) break;
#pragma unroll
        for (int a = 0; a < 2; ++a)
#pragma unroll
            for (int b = 0; b < 2; ++b)
#pragma unroll
                for (int m = 0; m < 4; ++m)
#pragma unroll
                    for (int n = 0; n < 2; ++n) acc[a][b][m][n] = (f32x4){0.f, 0.f, 0.f, 0.f};
        cur = nxt; cA = nA; cB = nB; ++ui;
    }
    PG8_WAIT_V(0);
    if (wr == 0) PG8_BAR;
    PG8_BAR;
    if constexpr (Epi::AFTER_DRAIN) { E.fused(acc, cur, wr, wc, fr, fq, lds, wid, lane); S.done(cur); }
    PG8_STAMP();
    if (STAMP && wid == 0) { stamps[lane] = lane < nts ? (((unsigned long long)(unsigned)ts_hi << 32) | (unsigned)ts_lo) : 0ull;
        if (lane == 62) stamps[62] = rt_entry; if (lane == 63) stamps[63] = (unsigned long long)wall_clock64(); }
#undef PG8_STAMP
#undef PG8_SA
#undef PG8_SB
#undef PG8_STAGE
#undef PG8_LDA
#undef PG8_LDB
#undef PG8_MMA
#undef PG8_WAIT_V
#undef PG8_WAIT_L
#undef PG8_BAR
#undef PG8_SCHED
}
}
using pg8::bf16_t; using pg8::bf16x8; using pg8::f32x4; using pg8::u32x4; using pg8::Unit;
typedef float f32x16 __attribute__((ext_vector_type(16)));
typedef float f32x2 __attribute__((ext_vector_type(2)));
typedef unsigned u32x2 __attribute__((ext_vector_type(2)));
typedef short s16x4 __attribute__((ext_vector_type(4)));
typedef __bf16 bf16x2v __attribute__((ext_vector_type(2)));
#define DI __device__ __forceinline__
#define LAS __attribute__((address_space(3)))

constexpr int MT = 16384, DM = 1024, DFF = 2816, SEQ = 2048, NBATCH = 8;
constexpr int GLA_N = 3104, MLA_N = 1088;
constexpr float EPS = 1e-6f;
constexpr int LDS_BYTES = 147456;
constexpr int LDS_XB_OFF = LDS_BYTES - 16;
constexpr int LDS_DUMMY = 0;

constexpr size_t SZ_WGU = (size_t)5632 * 1024 * 2, SZ_WD = (size_t)1024 * 2816 * 2;
constexpr size_t WS_WGU = 0;
constexpr size_t WS_WD = WS_WGU + 8 * SZ_WGU;
constexpr size_t WS_GWIN = WS_WD + 8 * SZ_WD;
constexpr size_t WS_GWG = WS_GWIN + 2 * (size_t)3072 * 1024 * 2;
constexpr size_t WS_GWOUT = WS_GWG + 2 * (size_t)32 * 1024 * 2;
constexpr size_t WS_MWIN = WS_GWOUT + 2 * (size_t)1024 * 1024 * 2;
constexpr size_t WS_MWKPE = WS_MWIN + 2 * (size_t)1024 * 1024 * 2;
constexpr size_t WS_MWUQ = WS_MWKPE + 2 * (size_t)64 * 1024 * 2;
constexpr size_t WS_MWUKV = WS_MWUQ + 2 * (size_t)1536 * 768 * 2;
constexpr size_t WS_MWOUT = WS_MWUKV + 2 * (size_t)2048 * 256 * 2;
constexpr size_t WS_XRES = WS_MWOUT + 2 * (size_t)1024 * 1024 * 2;
constexpr size_t WS_XB = WS_XRES + (size_t)MT * 1024 * 4;
constexpr size_t WS_ACT = WS_XB + (size_t)MT * 1024 * 2;
constexpr size_t WS_SSQ = WS_ACT + (size_t)MT * 2816 * 2;
constexpr size_t WS_SSQQ = WS_SSQ + (size_t)13 * MT * 16 * 4;
constexpr size_t WS_COS = WS_SSQQ + (size_t)2 * MT * 16 * 4;
constexpr size_t WS_SIN = WS_COS + (size_t)MT * 32 * 4;
constexpr size_t WS_MIX = WS_SIN + (size_t)MT * 32 * 4;
constexpr size_t WS_G = WS_MIX;
constexpr size_t WS_GG = WS_G + (size_t)MT * 3072 * 2;
constexpr size_t WS_OFW = WS_GG + (size_t)MT * 32 * 4;
constexpr size_t WS_OBW = WS_OFW + (size_t)MT * 1024 * 2;
constexpr size_t WS_ON = WS_OBW + (size_t)MT * 1024 * 2;
constexpr size_t WS_GIMG = WS_ON + (size_t)MT * 1024 * 2;
constexpr size_t WS_GLA_END = WS_GIMG + (size_t)2048 * 49664;
constexpr size_t WS_CQ = WS_MIX;
constexpr size_t WS_CKV = WS_CQ + (size_t)MT * 768 * 2;
constexpr size_t WS_Q = WS_CKV + (size_t)MT * 256 * 2;
constexpr size_t WS_KB = WS_Q + (size_t)MT * 8 * 192 * 2;
constexpr size_t WS_VB = WS_KB + (size_t)MT * 8 * 192 * 2;
constexpr size_t WS_O = WS_VB + (size_t)MT * 8 * 128 * 2;
constexpr size_t WS_MLA_END = WS_O + (size_t)MT * 1024 * 2;
constexpr size_t WS_BAR = WS_GLA_END > WS_MLA_END ? WS_GLA_END : WS_MLA_END;
constexpr size_t WS_BAR_BYTES = 3456 * 4;
constexpr size_t WS_END = WS_BAR + WS_BAR_BYTES;

struct Params {
    const float* in[18];
    float* out;
    unsigned char* ws;
    float inv_freq[32];
    int ph_lo, ph_hi;
};
enum { I_X = 0, I_POS, I_FFN_NORM, I_FFN_WGU, I_FFN_WD, I_MIX_NORM, I_GLA_WIN, I_GLA_WG2, I_GLA_BG, I_GLA_HN, I_GLA_WOUT,
       I_MLA_WIN, I_MLA_QN, I_MLA_KVN, I_MLA_WUQ, I_MLA_WUKV, I_MLA_WOUT, I_FINAL_NORM };

DI unsigned pk2(float a, float b) { f32x2 v = {a, b}; bf16x2v r = __builtin_convertvector(v, bf16x2v); return __builtin_bit_cast(unsigned, r); }
DI float bf2f(bf16_t v) { return __uint_as_float(((unsigned)v) << 16); }
DI float bflo(unsigned w) { return __uint_as_float(w << 16); }
DI float bfhi(unsigned w) { return __uint_as_float(w & 0xffff0000u); }
DI float silu_f(float g) { return g * __builtin_amdgcn_rcpf(1.0f + __expf(-g)); }
DI u32x4 pack8(const f32x4& a, const f32x4& b) { u32x4 w; w.x = pk2(a[0], a[1]); w.y = pk2(a[2], a[3]); w.z = pk2(b[0], b[1]); w.w = pk2(b[2], b[3]); return w; }
DI unsigned char* lws(const Params& p) { unsigned char* w = p.ws; asm volatile("" : "+s"(w)); return w; }
DI float* lout(const Params& p) { float* w = p.out; asm volatile("" : "+s"(w)); return w; }
DI const float* IN(const Params& p, int i) { const float* w = p.in[i]; asm volatile("" : "+s"(w)); return w; }
DI float sum16(const float* s) { const f32x4 a = *(const f32x4*)s, b = *(const f32x4*)(s + 4), c = *(const f32x4*)(s + 8), d = *(const f32x4*)(s + 12);
    return ((a[0] + a[1]) + (a[2] + a[3])) + ((b[0] + b[1]) + (b[2] + b[3])) + ((c[0] + c[1]) + (c[2] + c[3])) + ((d[0] + d[1]) + (d[2] + d[3])); }
DI float row_rstd(const float* ssqp, int row) { return rsqrtf(sum16(ssqp + (size_t)row * 16) * (1.0f / 1024.0f) + EPS); }
#define XB_TMO      128
#define XB_XCNT(j)  (256  + 64 * (j))
#define XB_XSUB(j)  (1280 + 64 * (j))
#define XB_XGEN(j)  (2304 + 64 * (j))
#define XB_TOP      3328
#define XB_TOPGEN   3392
#define XCD_BAR_WORDS 3456
#define XB_SPIN_CAP (1u << 22)

__device__ __forceinline__ unsigned xb_ld(unsigned* p)              { return __hip_atomic_load(p, __ATOMIC_RELAXED, __HIP_MEMORY_SCOPE_AGENT); }
__device__ __forceinline__ unsigned xb_add(unsigned* p, unsigned v) { return __hip_atomic_fetch_add(p, v, __ATOMIC_RELAXED, __HIP_MEMORY_SCOPE_AGENT); }
__device__ __forceinline__ unsigned xb_xcc_id() { return (unsigned)__builtin_amdgcn_s_getreg((3 << 11) | 20) & 0xFu; }
#define XB_SPIN(cond, bar) do { unsigned _sp = 0; while (cond) { __builtin_amdgcn_s_sleep(1); \
    if ((++_sp & 255u) == 0u) { if (xb_ld(&(bar)[XB_TMO])) break; if (_sp > XB_SPIN_CAP) { atomicAdd(&(bar)[XB_TMO], 1u); break; } } } } while (0)

struct XcdBarrier {
    unsigned* bar; unsigned x;
    volatile LAS unsigned* st;
};

__device__ __forceinline__ XcdBarrier xcd_barrier_post(unsigned* bar, volatile LAS unsigned* st) {
    XcdBarrier b; b.bar = bar; b.x = xb_xcc_id(); b.st = st;
    if (threadIdx.x == 0) (void)xb_add(&bar[XB_XCNT(b.x)], 1u);
    return b;
}
__device__ __forceinline__ void xcd_barrier_complete(unsigned* bar, unsigned x, unsigned& nloc, unsigned& nx) {
    const unsigned G = gridDim.x * gridDim.y * gridDim.z;
    unsigned sum, cnt, mine, sp = 0u;
    for (;;) {
        sum = 0u; cnt = 0u; mine = 0u;
#pragma unroll
        for (unsigned j = 0; j < 16; ++j) { const unsigned c = xb_ld(&bar[XB_XCNT(j)]); sum += c; cnt += (c > 0u) ? 1u : 0u; mine = (j == x) ? c : mine; }
        if (sum == G) break;
        __builtin_amdgcn_s_sleep(1);
        if ((++sp & 255u) == 0u) { if (xb_ld(&bar[XB_TMO])) break; if (sp > XB_SPIN_CAP) { atomicAdd(&bar[XB_TMO], 1u); break; } }
    }
    nloc = mine > 0u ? mine : 1u; nx = cnt > 0u ? cnt : 1u;
}

__device__ __forceinline__ void xcd_barrier(const XcdBarrier& b) {
    asm volatile("s_waitcnt vmcnt(0)" ::: "memory");
    __syncthreads();
    if (threadIdx.x == 0) {
        unsigned* bar = b.bar;
        __builtin_amdgcn_s_waitcnt(0);
        unsigned nloc = b.st[0], nx = b.st[1];
        if (nloc == 0u) { xcd_barrier_complete(bar, b.x, nloc, nx); b.st[0] = nloc; b.st[1] = nx; }
        const unsigned old = xb_add(&bar[XB_XSUB(b.x)], 1u);
        const unsigned gen = old / nloc;
        if (old + 1u == (gen + 1u) * nloc) {
            __builtin_amdgcn_fence(__ATOMIC_RELEASE, "agent");
            asm volatile("s_waitcnt vmcnt(0)" ::: "memory");
            const unsigned og = xb_add(&bar[XB_TOP], 1u);
            const unsigned tg = og / nx;
            if (og + 1u == (tg + 1u) * nx) xb_add(&bar[XB_TOPGEN], 1u);
            else XB_SPIN(xb_ld(&bar[XB_TOPGEN]) == tg, bar);
            __builtin_amdgcn_fence(__ATOMIC_ACQUIRE, "agent");
            xb_add(&bar[XB_XGEN(b.x)], 1u);
            asm volatile("s_waitcnt vmcnt(0)" ::: "memory");
        } else {
            XB_SPIN(xb_ld(&bar[XB_XGEN(b.x)]) == gen, bar);
            __builtin_amdgcn_fence(__ATOMIC_ACQUIRE, "agent");
            asm volatile("s_waitcnt vmcnt(0)" ::: "memory");
        }
    }
    __syncthreads();
}

struct CvtJob { const float* src; const float* gain; bf16_t* dst; int K, ldn, N, mode, coloff; };
DI int cvt_map(int mode, int coloff, int n) {
    if (mode == 1) { const int pn = n >> 8, bj = (n >> 7) & 1, i = n & 127; return bj * DFF + pn * 128 + i; }
    if (mode == 2) { if (n < 1024) return (n >> 7) * 192 + (n & 127); const int cr = n - 1024, head = cr >> 6, idx = cr & 63; return head * 192 + 128 + (idx & 1) * 32 + (idx >> 1); }
    return coloff + n;
}
DI CvtJob get_job(const Params& p, int idx) {
    CvtJob j; j.gain = nullptr; j.mode = 0; j.coloff = 0;
    unsigned char* ws = lws(p);
    if (idx < 16) { const int t = idx >> 1;
        if ((idx & 1) == 0) { j.src = IN(p, I_FFN_WGU) + (size_t)t * 1024 * 5632; j.gain = IN(p, I_FFN_NORM) + t * 1024; j.dst = (bf16_t*)(ws + WS_WGU + t * SZ_WGU); j.K = 1024; j.ldn = 5632; j.N = 5632; j.mode = 1; }
        else { j.src = IN(p, I_FFN_WD) + (size_t)t * 2816 * 1024; j.dst = (bf16_t*)(ws + WS_WD + t * SZ_WD); j.K = 2816; j.ldn = 1024; j.N = 1024; }
    } else if (idx < 22) { const int g = (idx - 16) / 3, w = (idx - 16) % 3;
        if (w == 0) { j.src = IN(p, I_GLA_WIN) + (size_t)g * 1024 * GLA_N; j.gain = IN(p, I_MIX_NORM) + (2 * g) * 1024; j.dst = (bf16_t*)(ws + WS_GWIN + (size_t)g * 3072 * 1024 * 2); j.K = 1024; j.ldn = GLA_N; j.N = 3072; }
        else if (w == 1) { j.src = IN(p, I_GLA_WIN) + (size_t)g * 1024 * GLA_N; j.gain = IN(p, I_MIX_NORM) + (2 * g) * 1024; j.dst = (bf16_t*)(ws + WS_GWG + (size_t)g * 32 * 1024 * 2); j.K = 1024; j.ldn = GLA_N; j.N = 32; j.coloff = 3072; }
        else { j.src = IN(p, I_GLA_WOUT) + (size_t)g * 1024 * 1024; j.dst = (bf16_t*)(ws + WS_GWOUT + (size_t)g * 1024 * 1024 * 2); j.K = 1024; j.ldn = 1024; j.N = 1024; }
    } else { const int g = (idx - 22) / 5, w = (idx - 22) % 5;
        if (w == 0) { j.src = IN(p, I_MLA_WIN) + (size_t)g * 1024 * MLA_N; j.gain = IN(p, I_MIX_NORM) + (2 * g + 1) * 1024; j.dst = (bf16_t*)(ws + WS_MWIN + (size_t)g * 1024 * 1024 * 2); j.K = 1024; j.ldn = MLA_N; j.N = 1024; }
        else if (w == 1) { j.src = IN(p, I_MLA_WIN) + (size_t)g * 1024 * MLA_N; j.gain = IN(p, I_MIX_NORM) + (2 * g + 1) * 1024; j.dst = (bf16_t*)(ws + WS_MWKPE + (size_t)g * 64 * 1024 * 2); j.K = 1024; j.ldn = MLA_N; j.N = 64; j.coloff = 1024; }
        else if (w == 2) { j.src = IN(p, I_MLA_WUQ) + (size_t)g * 768 * 1536; j.gain = IN(p, I_MLA_QN) + g * 768; j.dst = (bf16_t*)(ws + WS_MWUQ + (size_t)g * 1536 * 768 * 2); j.K = 768; j.ldn = 1536; j.N = 1536; j.mode = 2; }
        else if (w == 3) { j.src = IN(p, I_MLA_WUKV) + (size_t)g * 256 * 2048; j.gain = IN(p, I_MLA_KVN) + g * 256; j.dst = (bf16_t*)(ws + WS_MWUKV + (size_t)g * 2048 * 256 * 2); j.K = 256; j.ldn = 2048; j.N = 2048; }
        else { j.src = IN(p, I_MLA_WOUT) + (size_t)g * 1024 * 1024; j.dst = (bf16_t*)(ws + WS_MWOUT + (size_t)g * 1024 * 1024 * 2); j.K = 1024; j.ldn = 1024; j.N = 1024; }
    }
    return j;
}
constexpr unsigned CVT_L0 = 0x00030003u, CVT_S0 = 0x07fc03fcu, CVT_S2 = 0xf800fc00u;
static_assert((CVT_L0 | CVT_S0 | CVT_S2) == 0xffffffffu && (CVT_L0 & CVT_S0) == 0u && (CVT_L0 & CVT_S2) == 0u && (CVT_S0 & CVT_S2) == 0u, "job sets");
DI void cvt_weights(const Params& p, unsigned mask, int b0, int nb) {
    const int tid = otid(), nn = tid & 31, kk = tid >> 5;
    for (int ji = 0; ji < 32; ++ji) {
        if (!((mask >> ji) & 1u)) continue;
        const CvtJob j = get_job(p, ji);
        const int ntk = j.K >> 7, ntn = j.N >> 5, nt = ntk * ntn;
        for (int t = obid() - b0; t < nt; t += nb) {
            const int tn = t % ntn, tk = t / ntn;
            const int n = tn * 32 + nn, k0 = tk * 128 + kk * 8;
            const int sc = cvt_map(j.mode, j.coloff, n);
            const float* sp = j.src + (size_t)k0 * j.ldn + sc;
            float v[8];
#pragma unroll
            for (int e = 0; e < 8; ++e) v[e] = sp[(size_t)e * j.ldn];
            if (j.gain) {
#pragma unroll
                for (int e = 0; e < 8; ++e) v[e] *= j.gain[k0 + e];
            }
            u32x4 w; w.x = pk2(v[0], v[1]); w.y = pk2(v[2], v[3]); w.z = pk2(v[4], v[5]); w.w = pk2(v[6], v[7]);
            *(u32x4*)(j.dst + (size_t)n * j.K + k0) = w;
        }
    }
}
DI void prep_phase(const Params& p) {
    const int tid = otid(), lane = tid & 63, wv = obid() * 8 + (tid >> 6), nwv = ogrid() * 8;
    unsigned char* ws = lws(p);
    { const float* x = IN(p, I_X); bf16_t* xb = (bf16_t*)(ws + WS_XB); float* ssq0 = (float*)(ws + WS_SSQ);
      for (int row = wv; row < MT; row += nwv) {
          const f32x4* s = (const f32x4*)(x + (size_t)row * 1024); float ss = 0.f;
#pragma unroll
          for (int i = 0; i < 4; ++i) { const f32x4 v = s[lane + 64 * i]; u32x2 w; w.x = pk2(v[0], v[1]); w.y = pk2(v[2], v[3]);
              ss += (bflo(w.x) * bflo(w.x) + bfhi(w.x) * bfhi(w.x)) + (bflo(w.y) * bflo(w.y) + bfhi(w.y) * bfhi(w.y));
              ((u32x2*)(xb + (size_t)row * 1024))[lane + 64 * i] = w; }
#pragma unroll
          for (int o = 32; o >= 1; o >>= 1) ss += __shfl_xor(ss, o);
          if (lane < 16) ssq0[(size_t)row * 16 + lane] = lane == 0 ? ss : 0.f;
      } }
    { const int* pos = (const int*)IN(p, I_POS); float* ct = (float*)(ws + WS_COS); float* st = (float*)(ws + WS_SIN);
      for (int i = obid() * 512 + tid; i < MT * 32; i += ogrid() * 512) {
          const int row = i >> 5, f = i & 31; const float ang = (float)pos[row] * p.inv_freq[f];
          double t = (double)ang * 0.15915494309189533577; t -= floor(t); const float tf = (float)t;
          ct[i] = __builtin_amdgcn_cosf(tf); st[i] = __builtin_amdgcn_sinf(tf); } }
    cvt_weights(p, ogrid() > 64 ? CVT_L0 : 0xffffffffu, 0, ogrid());
}

constexpr int LDS_RTAB = 131072, LDS_PMTAB = LDS_RTAB + 6 * 256 * 4;
static_assert(LDS_PMTAB + 32 <= LDS_XB_OFF, "rstd table");
struct RstdTab { const float* r; const int* pm;
    DI int slot(int upm) const { int s = 0;
#pragma unroll
        for (int i = 5; i >= 0; --i) s = (pm[i] == upm) ? i : s;
        return s; }
    DI float get(int s, int rowin) const { return r[s * 256 + rowin]; } };
DI RstdTab fill_rstd(unsigned char* shm, int N, const float* ssqp, int slot0, int nslots, float invn, int uneven = 0) {
    float* rt = (float*)(shm + LDS_RTAB); int* pt = (int*)(shm + LDS_PMTAB);
    const int tid = otid(), half = tid >> 8, rowin = tid & 255;
    pg8::StaticOrder S; S.init(MT, N, ogrid(), obid()); S.uneven = uneven;
    __syncthreads();
    for (int i0 = 0; i0 < 6; i0 += 2) { const int i = i0 + half; Unit u; u.pm = 0; u.pn = 0; const bool ok = S.next(i, u);
        if (rowin == 0) pt[i] = ok ? u.pm : -1;
        if (ok) { const float* sp = ssqp + (size_t)(u.pm * 256 + rowin) * 16 + slot0; float s = 0.f;
            for (int k = 0; k < nslots; k += 4) { const f32x4 v = *(const f32x4*)(sp + k); s += (v[0] + v[1]) + (v[2] + v[3]); }
            rt[i * 256 + rowin] = rsqrtf(s * invn + EPS); } }
    __syncthreads();
    RstdTab t; t.r = rt; t.pm = pt; return t;
}

struct EpiGateUp { static constexpr bool PERM = true, AFTER_DRAIN = false;
    bf16_t* act; RstdTab rt;
    DI void operator()(const f32x4 (&acc)[2][2][4][2], const Unit& u, int wr, int wc, int fr, int fq) const {
        const int row0 = u.pm * 256 + wr * 64 + fr, col0 = u.pn * 128 + wc * 32 + 8 * fq; const int ts = rt.slot(u.pm);
#pragma unroll
        for (int ai = 0; ai < 2; ++ai)
#pragma unroll
            for (int m = 0; m < 4; ++m) { const int row = row0 + ai * 128 + m * 16; const float rs = rt.get(ts, row & 255);
                f32x4 a0, a1;
#pragma unroll
                for (int e = 0; e < 4; ++e) { a0[e] = silu_f(acc[ai][0][m][0][e] * rs) * (acc[ai][1][m][0][e] * rs); a1[e] = silu_f(acc[ai][0][m][1][e] * rs) * (acc[ai][1][m][1][e] * rs); }
                *(u32x4*)(act + (size_t)row * DFF + col0) = pack8(a0, a1); }
    }
};
struct EpiResid { static constexpr bool PERM = true, AFTER_DRAIN = false;
    bf16_t* xb; float* ssq_out; float alpha;
    DI void operator()(const f32x4 (&acc)[2][2][4][2], const Unit& u, int wr, int wc, int fr, int fq) const {
        const int row0 = u.pm * 256 + wr * 64 + fr, col0 = u.pn * 256 + wc * 32 + 8 * fq;
#pragma unroll
        for (int ai = 0; ai < 2; ++ai) {
            u32x4 xin[4][2];
#pragma unroll
            for (int m = 0; m < 4; ++m) { const bf16_t* bp = xb + (size_t)(row0 + ai * 128 + m * 16) * 1024 + col0; xin[m][0] = *(const u32x4*)bp; xin[m][1] = *(const u32x4*)(bp + 128); }
#pragma unroll
            for (int m = 0; m < 4; ++m) { const int row = row0 + ai * 128 + m * 16; bf16_t* bp = xb + (size_t)row * 1024 + col0; float s = 0.f;
#pragma unroll
                for (int bj = 0; bj < 2; ++bj) { const u32x4 xi = xin[m][bj]; f32x4 x0, x1;
                    x0[0] = bflo(xi[0]); x0[1] = bfhi(xi[0]); x0[2] = bflo(xi[1]); x0[3] = bfhi(xi[1]); x1[0] = bflo(xi[2]); x1[1] = bfhi(xi[2]); x1[2] = bflo(xi[3]); x1[3] = bfhi(xi[3]);
                    x0 += alpha * acc[ai][bj][m][0]; x1 += alpha * acc[ai][bj][m][1];
                    const u32x4 w = pack8(x0, x1); *(u32x4*)(bp + bj * 128) = w;
#pragma unroll
                    for (int e = 0; e < 4; ++e) { const float lo = bflo(w[e]), hi = bfhi(w[e]); s += lo * lo + hi * hi; } }
                s += __shfl_xor(s, 16); s += __shfl_xor(s, 32);
                if (fq == 0) ssq_out[(size_t)row * 16 + u.pn * 4 + wc] = s; }
        }
    }
};
struct EpiGlaIn { static constexpr bool PERM = true, AFTER_DRAIN = false;
    bf16_t* G; RstdTab rt;
    DI void operator()(const f32x4 (&acc)[2][2][4][2], const Unit& u, int wr, int wc, int fr, int fq) const {
        const int row0 = u.pm * 256 + wr * 64 + fr, col0 = u.pn * 256 + wc * 32 + 8 * fq; const float sc = u.pn < 2 ? 0.08838834764831845f : 1.0f; const int ts = rt.slot(u.pm);
#pragma unroll
        for (int ai = 0; ai < 2; ++ai)
#pragma unroll
            for (int m = 0; m < 4; ++m) { const int row = row0 + ai * 128 + m * 16; const float rs = rt.get(ts, row & 255) * sc;
#pragma unroll
                for (int bj = 0; bj < 2; ++bj) *(u32x4*)(G + (size_t)row * 3072 + col0 + bj * 128) = pack8(acc[ai][bj][m][0] * rs, acc[ai][bj][m][1] * rs); }
    }
};
struct EpiMlaIn { static constexpr bool PERM = true, AFTER_DRAIN = false;
    bf16_t* cq; bf16_t* ckv; RstdTab rt; float* ssq_qkv;
    DI void operator()(const f32x4 (&acc)[2][2][4][2], const Unit& u, int wr, int wc, int fr, int fq) const {
        const int row0 = u.pm * 256 + wr * 64 + fr, cw = wc * 32 + 8 * fq; const bool isq = u.pn < 3; const int ts = rt.slot(u.pm);
#pragma unroll
        for (int ai = 0; ai < 2; ++ai)
#pragma unroll
            for (int m = 0; m < 4; ++m) { const int row = row0 + ai * 128 + m * 16; const float rs = rt.get(ts, row & 255); float s = 0.f;
                bf16_t* dst = isq ? cq + (size_t)row * 768 + u.pn * 256 + cw : ckv + (size_t)row * 256 + cw;
#pragma unroll
                for (int bj = 0; bj < 2; ++bj) { const f32x4 v0 = acc[ai][bj][m][0] * rs, v1 = acc[ai][bj][m][1] * rs;
                    s += v0[0] * v0[0] + v0[1] * v0[1] + v0[2] * v0[2] + v0[3] * v0[3] + v1[0] * v1[0] + v1[1] * v1[1] + v1[2] * v1[2] + v1[3] * v1[3];
                    *(u32x4*)(dst + bj * 128) = pack8(v0, v1); }
                s += __shfl_xor(s, 16); s += __shfl_xor(s, 32);
                if (fq == 0) ssq_qkv[(size_t)row * 16 + u.pn * 4 + wc] = s; }
    }
};
struct EpiUq { static constexpr bool PERM = true, AFTER_DRAIN = false;
    bf16_t* Q; RstdTab rt; const float* ct; const float* st;
    DI void operator()(const f32x4 (&acc)[2][2][4][2], const Unit& u, int wr, int wc, int fr, int fq) const {
        const int row0 = u.pm * 256 + wr * 64 + fr; const int ts = rt.slot(u.pm);
        if (u.pn < 4) {
#pragma unroll
            for (int ai = 0; ai < 2; ++ai)
#pragma unroll
                for (int m = 0; m < 4; ++m) { const int row = row0 + ai * 128 + m * 16; const float rs = rt.get(ts, row & 255); const int b = row >> 11, s = row & 2047;
#pragma unroll
                    for (int bj = 0; bj < 2; ++bj) { const int head = 2 * u.pn + bj;
                        *(u32x4*)(Q + ((size_t)(b * 8 + head) * SEQ + s) * 192 + wc * 32 + 8 * fq) = pack8(acc[ai][bj][m][0] * rs, acc[ai][bj][m][1] * rs); } }
        } else {
            const int i0 = 16 * (wc & 1) + 4 * fq;
#pragma unroll
            for (int ai = 0; ai < 2; ++ai)
#pragma unroll
                for (int m = 0; m < 4; ++m) { const int row = row0 + ai * 128 + m * 16; const float rs = rt.get(ts, row & 255); const int b = row >> 11, s = row & 2047;
                    const f32x4 c = *(const f32x4*)(ct + (size_t)row * 32 + i0) * rs, sn = *(const f32x4*)(st + (size_t)row * 32 + i0) * rs;
#pragma unroll
                    for (int bj = 0; bj < 2; ++bj) { const int head = 4 * (u.pn - 4) + 2 * bj + (wc >> 1);
                        const f32x4 v0 = acc[ai][bj][m][0], v1 = acc[ai][bj][m][1]; f32x4 o0, o1;
                        o0[0] = v0[0] * c[0] - v0[1] * sn[0]; o0[1] = v0[1] * c[0] + v0[0] * sn[0];
                        o0[2] = v0[2] * c[1] - v0[3] * sn[1]; o0[3] = v0[3] * c[1] + v0[2] * sn[1];
                        o1[0] = v1[0] * c[2] - v1[1] * sn[2]; o1[1] = v1[1] * c[2] + v1[0] * sn[2];
                        o1[2] = v1[2] * c[3] - v1[3] * sn[3]; o1[3] = v1[3] * c[3] + v1[2] * sn[3];
                        *(u32x4*)(Q + ((size_t)(b * 8 + head) * SEQ + s) * 192 + 128 + 32 * (wc & 1) + 8 * fq) = pack8(o0, o1); }
                    asm volatile("" ::: "memory"); }
        }
    }
};
struct EpiUkv { static constexpr bool PERM = true, AFTER_DRAIN = false;
    bf16_t* Kb; bf16_t* Vb; RstdTab rt;
    DI void operator()(const f32x4 (&acc)[2][2][4][2], const Unit& u, int wr, int wc, int fr, int fq) const {
        const int row0 = u.pm * 256 + wr * 64 + fr; const int ts = rt.slot(u.pm);
#pragma unroll
        for (int ai = 0; ai < 2; ++ai)
#pragma unroll
            for (int m = 0; m < 4; ++m) { const int row = row0 + ai * 128 + m * 16; const float rs = rt.get(ts, row & 255);
                const int b = row >> 11, s = row & 2047; const size_t tr = (size_t)(b * 8 + u.pn) * SEQ + s;
                *(u32x4*)(Kb + tr * 192 + wc * 32 + 8 * fq) = pack8(acc[ai][0][m][0] * rs, acc[ai][0][m][1] * rs);
                *(u32x4*)(Vb + tr * 128 + wc * 32 + 8 * fq) = pack8(acc[ai][1][m][0] * rs, acc[ai][1][m][1] * rs); }
    }
};
template <class Epi> DI void run_gemm(LAS unsigned char* lds, const bf16_t* A, const bf16_t* Bt, int N, int K, const Epi& E, int uneven = 0) {
    asm volatile("" : "+s"(K));
    pg8::Gemm g; g.A = A; g.Bt = Bt; g.M = MT; g.N = N; g.K = K;
    pg8::StaticOrder S; S.init(MT, N, ogrid(), obid()); S.uneven = uneven;
    pg8::gemm_phase<Epi, pg8::StaticOrder, false>(lds, g, S, E, nullptr);
}

template <int NBLK, int MODE> DI void skinny_gemm(const bf16_t* xb, const bf16_t* Bt, const float* ssq, float* gg, bf16_t* Kb, const float* ct, const float* st, unsigned char* lds) {
    const int tid = otid(), lane = tid & 63, w = tid >> 6, r = lane & 31, h = lane >> 5, rt = w >> 2, kq = w & 3;
    float* red = (float*)lds;
    for (int rb = obid(); rb < MT / 64; rb += ogrid()) {
        const int row0 = rb * 64 + rt * 32;
        f32x16 acc[NBLK];
#pragma unroll
        for (int nb = 0; nb < NBLK; ++nb)
#pragma unroll
            for (int i = 0; i < 16; ++i) acc[nb][i] = 0.f;
        const bf16_t* ap = xb + (size_t)(row0 + r) * 1024 + kq * 256 + 8 * h;
        const bf16_t* bp = Bt + (size_t)r * 1024 + kq * 256 + 8 * h;
#pragma unroll 4
        for (int k0 = 0; k0 < 256; k0 += 16) {
            const bf16x8 a = *(const bf16x8*)(ap + k0);
#pragma unroll
            for (int nb = 0; nb < NBLK; ++nb) { const bf16x8 b = *(const bf16x8*)(bp + (size_t)nb * 32 * 1024 + k0);
                acc[nb] = __builtin_amdgcn_mfma_f32_32x32x16_bf16(a, b, acc[nb], 0, 0, 0); }
        }
        __syncthreads();
#pragma unroll
        for (int nb = 0; nb < NBLK; ++nb)
#pragma unroll
            for (int i = 0; i < 16; ++i) red[((w * NBLK + nb) * 16 + i) * 64 + lane] = acc[nb][i];
        __syncthreads();
        if (kq == 0) {
#pragma unroll
            for (int nb = 0; nb < NBLK; ++nb)
#pragma unroll
                for (int i = 0; i < 16; ++i) acc[nb][i] = (red[(((w + 0) * NBLK + nb) * 16 + i) * 64 + lane] + red[(((w + 1) * NBLK + nb) * 16 + i) * 64 + lane])
                                                         + (red[(((w + 2) * NBLK + nb) * 16 + i) * 64 + lane] + red[(((w + 3) * NBLK + nb) * 16 + i) * 64 + lane]);
#pragma unroll
            for (int i = 0; i < 16; ++i) { const int row = row0 + (i & 3) + 8 * (i >> 2) + 4 * h; const float rs = row_rstd(ssq, row);
                if (MODE == 0) { gg[(size_t)row * 32 + r] = acc[0][i] * rs; }
                else { const float x1 = acc[0][i] * rs, x2 = acc[NBLK - 1][i] * rs, c = ct[(size_t)row * 32 + r], sn = st[(size_t)row * 32 + r];
                    const unsigned wv = pk2(x1 * c - x2 * sn, x2 * c + x1 * sn); const int b = row >> 11, s = row & 2047;
#pragma unroll
                    for (int hd = 0; hd < 8; ++hd) *(unsigned*)(Kb + ((size_t)(b * 8 + hd) * SEQ + s) * 192 + 128 + 2 * r) = wv; } }
        }
    }
}
namespace att {
constexpr int DQ = 192, DV = 128, NW = 8, QBLK = 32, KVBLK = 64;
constexpr float SCALE = 0.07216878364870322f;
constexpr float THR = 8.f;
constexpr int SHM_V = KVBLK * DV * 2, SHM_K = KVBLK * DQ * 2, SHM_ATTN = 2 * SHM_V + 2 * SHM_K + NW * 64 * 4;
#define KSWZ(row, colB) ((row) * 384 + ((colB) ^ (((row) & 7) << 4)))
#define SBAR() __builtin_amdgcn_sched_barrier(0)
DI int crow(int r, int hi) { return (r & 3) + 8 * (r >> 2) + 4 * hi; }
DI void partialSM(f32x16& p0, f32x16& p1, float& m_reg, float& mn, float& alpha) {
    constexpr float C = SCALE * 1.4426950408889634f;
    float pmax = p0[0];
#pragma unroll
    for (int r = 1; r < 16; ++r) pmax = fmaxf(pmax, p0[r]);
#pragma unroll
    for (int r = 0; r < 16; ++r) pmax = fmaxf(pmax, p1[r]);
    { auto rr = __builtin_amdgcn_permlane32_swap(__float_as_uint(pmax), __float_as_uint(pmax), false, false);
      pmax = fmaxf(__uint_as_float(rr[0]), __uint_as_float(rr[1])); }
    if (__builtin_expect(__all(pmax - m_reg <= THR / SCALE), 1)) { mn = m_reg; alpha = 1.f; }
    else { mn = fmaxf(m_reg, pmax); alpha = __builtin_amdgcn_exp2f((m_reg - mn) * C); m_reg = mn; }
    const float mnC = -mn * C;
#pragma unroll
    for (int r = 0; r < 16; ++r) p0[r] = fmaf(p0[r], C, mnC);
#pragma unroll
    for (int r = 0; r < 16; ++r) p1[r] = fmaf(p1[r], C, mnC);
#pragma unroll
    for (int r = 0; r < 16; ++r) p0[r] = __builtin_amdgcn_exp2f(p0[r]);
}
DI void finishSM(f32x16& p0, f32x16& p1, float alpha, float& l_reg, bf16x8& pa0, bf16x8& pa1, bf16x8& pa2, bf16x8& pa3) {
#pragma unroll
    for (int r = 0; r < 16; ++r) p1[r] = __builtin_amdgcn_exp2f(p1[r]);
    float ps = 0;
#pragma unroll
    for (int r = 0; r < 16; ++r) ps += p0[r];
#pragma unroll
    for (int r = 0; r < 16; ++r) ps += p1[r];
    { auto rr = __builtin_amdgcn_permlane32_swap(__float_as_uint(ps), __float_as_uint(ps), false, false);
      ps = __uint_as_float(rr[0]) + __uint_as_float(rr[1]); }
    l_reg = l_reg * alpha + ps;
#define PK4(P, BASE, OUT) do { unsigned a0 = pk2(P[BASE + 0], P[BASE + 1]), a1 = pk2(P[BASE + 2], P[BASE + 3]);   \
    unsigned b0 = pk2(P[BASE + 4], P[BASE + 5]), b1 = pk2(P[BASE + 6], P[BASE + 7]);                              \
    auto r0 = __builtin_amdgcn_permlane32_swap(a0, b0, false, false); auto r1 = __builtin_amdgcn_permlane32_swap(a1, b1, false, false); \
    u32x4 w = {r0[0], r1[0], r0[1], r1[1]}; OUT = __builtin_bit_cast(bf16x8, w); } while (0)
    PK4(p0, 0, pa0); PK4(p0, 8, pa1); PK4(p1, 0, pa2); PK4(p1, 8, pa3);
#undef PK4
}
DI void qkt(f32x16& p0, f32x16& p1, const char* Ks, const int (&kb)[4], const bf16x8* qr) {
#pragma unroll
    for (int i = 0; i < 16; ++i) { p0[i] = 0.f; p1[i] = 0.f; }
#pragma unroll
    for (int d0 = 0; d0 < 12; ++d0) {
        const bf16x8 b0 = *reinterpret_cast<const bf16x8*>(Ks + kb[d0 & 3] + (d0 >> 2) * 128);
        const bf16x8 b1 = *reinterpret_cast<const bf16x8*>(Ks + kb[d0 & 3] + (d0 >> 2) * 128 + 32 * 384);
        p0 = __builtin_amdgcn_mfma_f32_32x32x16_bf16(b0, qr[d0], p0, 0, 0, 0);
        p1 = __builtin_amdgcn_mfma_f32_32x32x16_bf16(b1, qr[d0], p1, 0, 0, 0); }
}
DI int v_st(int k, int c) { const int kk = (k & ~0xC) | ((k & 4) << 1) | ((k & 8) >> 1); return ((kk >> 3) * 4 + (c >> 5)) * 512 + ((kk & 7) * 32 + (c & 31)) * 2; }
DI int v_rd_base(int lane) { return ((lane & 3) << 3) | (((lane >> 2) & 3) << 6) | (((lane >> 4) & 1) << 5) | (((lane >> 5) & 1) << 8); }
constexpr int v_rd_off(int d0, int ks, int half) { return d0 * 512 + ks * 4096 + half * 2048; }
template <int OFF> DI s16x4 tr_read(int vb) { s16x4 r; asm volatile("ds_read_b64_tr_b16 %0, %1 offset:%2" : "=&v"(r) : "v"(vb), "i"(OFF) : "memory"); return r; }
template <int D0> DI void pv_one(f32x16& od, int vb, bf16x8 pa0, bf16x8 pa1, bf16x8 pa2, bf16x8 pa3) {
    const s16x4 l0 = tr_read<v_rd_off(D0, 0, 0)>(vb), h0 = tr_read<v_rd_off(D0, 0, 1)>(vb), l1 = tr_read<v_rd_off(D0, 1, 0)>(vb), h1 = tr_read<v_rd_off(D0, 1, 1)>(vb);
    const s16x4 l2 = tr_read<v_rd_off(D0, 2, 0)>(vb), h2 = tr_read<v_rd_off(D0, 2, 1)>(vb), l3 = tr_read<v_rd_off(D0, 3, 0)>(vb), h3 = tr_read<v_rd_off(D0, 3, 1)>(vb);
    asm volatile("s_waitcnt lgkmcnt(0)" ::: "memory"); SBAR();
#define PKV(L, H) (bf16x8){L[0], L[1], L[2], L[3], H[0], H[1], H[2], H[3]}
    od = __builtin_amdgcn_mfma_f32_32x32x16_bf16(pa0, PKV(l0, h0), od, 0, 0, 0);
    od = __builtin_amdgcn_mfma_f32_32x32x16_bf16(pa1, PKV(l1, h1), od, 0, 0, 0);
    od = __builtin_amdgcn_mfma_f32_32x32x16_bf16(pa2, PKV(l2, h2), od, 0, 0, 0);
    od = __builtin_amdgcn_mfma_f32_32x32x16_bf16(pa3, PKV(l3, h3), od, 0, 0, 0);
#undef PKV
}
DI void pv_d0(f32x16* o, int vb, bf16x8 pa0, bf16x8 pa1, bf16x8 pa2, bf16x8 pa3) {
    pv_one<0>(o[0], vb, pa0, pa1, pa2, pa3); pv_one<1>(o[1], vb, pa0, pa1, pa2, pa3); pv_one<2>(o[2], vb, pa0, pa1, pa2, pa3); pv_one<3>(o[3], vb, pa0, pa1, pa2, pa3);
}
DI void attn_body(const bf16_t* __restrict__ Qb, const bf16_t* __restrict__ Kh, const bf16_t* __restrict__ Vh, bf16_t* __restrict__ Ob, int seq, char* lds) {
    const int tid = otid(), wid = tid >> 6, lane = tid & 63, r32 = lane & 31, hi = lane >> 5;
    char* V_lds = lds; char* K_lds = lds + 2 * SHM_V;
    float* ws = (float*)(lds + 2 * SHM_V + 2 * SHM_K) + wid * 64; float* li_l = ws; float* al_l = ws + 32;
    float m_reg = -1e30f, l_reg = 0; f32x16 o[4];
#pragma unroll
    for (int d = 0; d < 4; ++d)
#pragma unroll
        for (int r = 0; r < 16; ++r) o[d][r] = 0.f;
    bf16x8 qr[12];
    const bf16_t* Qw = Qb + (size_t)(wid * QBLK + r32) * DQ + hi * 8;
#pragma unroll
    for (int d0 = 0; d0 < 12; ++d0) qr[d0] = *(const bf16x8*)(Qw + d0 * 16);
    const int sr = tid >> 4, sc = (tid & 15) * 8, vst0 = v_st(sr, sc), vst1 = v_st(32 + sr, sc);
    int krow_[3], kcp_[3];
#pragma unroll
    for (int i = 0; i < 3; ++i) { const int pc = tid + 512 * i; krow_[i] = pc / 24; kcp_[i] = pc % 24; }
    const int vb0 = (int)(uintptr_t)V_lds + v_rd_base(lane);
    int kb[4];
#pragma unroll
    for (int b = 0; b < 4; ++b) kb[b] = r32 * 384 + ((b * 32 + hi * 16) ^ ((r32 & 7) << 4));
    bf16x8 vs0, vs1, ks0, ks1, ks2;
#define SLOAD(k0) do { vs0 = *(const bf16x8*)(Vh + (size_t)((k0) + sr) * DV + sc); vs1 = *(const bf16x8*)(Vh + (size_t)((k0) + 32 + sr) * DV + sc); \
    ks0 = *(const bf16x8*)(Kh + (size_t)((k0) + krow_[0]) * DQ + kcp_[0] * 8); ks1 = *(const bf16x8*)(Kh + (size_t)((k0) + krow_[1]) * DQ + kcp_[1] * 8); \
    ks2 = *(const bf16x8*)(Kh + (size_t)((k0) + krow_[2]) * DQ + kcp_[2] * 8); } while (0)
#define SWRITE(b) do { *(bf16x8*)(V_lds + (b) * SHM_V + vst0) = vs0; *(bf16x8*)(V_lds + (b) * SHM_V + vst1) = vs1; \
    *(bf16x8*)(K_lds + (b) * SHM_K + KSWZ(krow_[0], kcp_[0] * 16)) = ks0; *(bf16x8*)(K_lds + (b) * SHM_K + KSWZ(krow_[1], kcp_[1] * 16)) = ks1; \
    *(bf16x8*)(K_lds + (b) * SHM_K + KSWZ(krow_[2], kcp_[2] * 16)) = ks2; } while (0)
#define RESC(a) do { if (__any((a) < 1.f)) { if (hi == 0) al_l[r32] = (a); asm volatile("s_waitcnt lgkmcnt(0)" ::: "memory"); \
    _Pragma("unroll") for (int d = 0; d < 4; ++d) _Pragma("unroll") for (int r = 0; r < 16; ++r) o[d][r] *= al_l[crow(r, hi)]; } } while (0)
    f32x16 p0, p1; float mn, al; bf16x8 pa0, pa1, pa2, pa3; const int NT = seq / KVBLK;
    SLOAD(0); SWRITE(0); __syncthreads();
    for (int j = 0; j < NT; ++j) {
        const int bsel = j & 1;
        if (j + 1 < NT) SLOAD((j + 1) * KVBLK);
        SBAR(); qkt(p0, p1, K_lds + bsel * SHM_K, kb, qr);
        partialSM(p0, p1, m_reg, mn, al);
        RESC(al);
        finishSM(p0, p1, al, l_reg, pa0, pa1, pa2, pa3); SBAR();
        pv_d0(o, vb0 + bsel * SHM_V, pa0, pa1, pa2, pa3);
        if (j + 1 < NT) SWRITE(bsel ^ 1);
        __syncthreads();
    }
    if (hi == 0) li_l[r32] = l_reg; asm volatile("s_waitcnt lgkmcnt(0)" ::: "memory");
    float rli[16];
#pragma unroll
    for (int r = 0; r < 16; ++r) rli[r] = __builtin_amdgcn_rcpf(li_l[crow(r, hi)]);
    bf16_t* Ow = Ob + (size_t)(wid * QBLK) * 1024;
#pragma unroll
    for (int r = 0; r < 16; ++r) { const int orow = crow(r, hi);
#pragma unroll
        for (int d0 = 0; d0 < 4; ++d0) { const unsigned w = pk2(o[d0][r] * rli[r], 0.f); Ow[(size_t)orow * 1024 + d0 * 32 + r32] = (bf16_t)(w & 0xffffu); } }
    __syncthreads();
#undef SLOAD
#undef SWRITE
#undef RESC
}

}
namespace gla {
DI bf16x8 packregs(const f32x16& x, int s) { u32x4 w; w.x = pk2(x[8 * s], x[8 * s + 1]); w.y = pk2(x[8 * s + 2], x[8 * s + 3]); w.z = pk2(x[8 * s + 4], x[8 * s + 5]); w.w = pk2(x[8 * s + 6], x[8 * s + 7]); return __builtin_bit_cast(bf16x8, w); }
}

namespace gla2 {
constexpr int ITEM_BYTES = 49152 + 512;
constexpr int P_B = 0, P_GG = 32768, P_SEG = P_GG + 4096, P_W2 = P_SEG + 2048;
constexpr int S_Q = 0, S_K = 16384, S_KH = 32768, S_EEND = 49152, S_V = 49664, S_P = S_V + 32768, S_END = S_P + 9216;
static_assert(S_END <= LDS_XB_OFF && P_W2 + 17 * 128 * 4 <= LDS_XB_OFF, "GLA LDS");
DI void prep(const Params& p, int j, unsigned char* lds) {
    const int tid = otid(); unsigned char* ws = lws(p);
    const bf16_t* G = (const bf16_t*)(ws + WS_G); const float* gg = (const float*)(ws + WS_GG); unsigned char* img = ws + WS_GIMG;
    const float* w2 = IN(p, I_GLA_WG2) + (size_t)j * 2 * 16 * 512; const float* bg = IN(p, I_GLA_BG) + (size_t)j * 2 * 512;
    float* L_B = (float*)(lds + P_B); float* L_GG = (float*)(lds + P_GG); float* L_SEG = (float*)(lds + P_SEG); float* L_W2 = (float*)(lds + P_W2);
    const int gd = tid & 127, seg = tid >> 7;
    for (int grp = obid(); grp < 256; grp += ogrid()) {
        const int unit = grp >> 2, b = unit >> 3, hd = (unit >> 1) & 3, dir = unit & 1, c0 = (grp & 3) * 8;
        const bf16_t* Gb = G + (size_t)b * SEQ * 3072 + hd * 128; const float* ggb = gg + (size_t)b * SEQ * 32 + dir * 16;
        __syncthreads();
        for (int i = tid; i < 17 * 128; i += 512) { const int jj = i >> 7, d = i & 127; L_W2[i] = jj < 16 ? w2[(dir * 16 + jj) * 512 + hd * 128 + d] : bg[dir * 512 + hd * 128 + d]; }
        u32x4 qreg[2], kreg[2]; f32x4 greg;
#define G2_PREFETCH(c) do { \
        _Pragma("unroll") for (int i = 0; i < 2; ++i) { const int pc = tid + 512 * i, t = pc >> 4, c8 = (pc & 15) * 8; const int tok = dir ? (SEQ - 1 - (64 * (c) + t)) : (64 * (c) + t); \
            const unsigned go = (unsigned)tok * 3072u + (unsigned)c8; qreg[i] = *(const u32x4*)(Gb + go); kreg[i] = *(const u32x4*)(Gb + go + 512u); } \
        if (tid < 256) { const int t = tid >> 2, part = tid & 3; const int tok = dir ? (SEQ - 1 - (64 * (c) + t)) : (64 * (c) + t); greg = *(const f32x4*)(ggb + ((unsigned)tok * 32u + (unsigned)(part * 4))); } } while (0)
        G2_PREFETCH(c0);
        for (int it = 0; it < 8; ++it) { const int c = c0 + it;
            unsigned char* ib = img + (size_t)(unit * 32 + c) * ITEM_BYTES;
            if (tid < 256) *(f32x4*)(L_GG + (tid >> 2) * 16 + (tid & 3) * 4) = greg;
            __syncthreads();
            float bl[16]; float run = 0.f; float wcol[16];
#pragma unroll
            for (int jj = 0; jj < 16; ++jj) wcol[jj] = L_W2[jj * 128 + gd];
            const float bias = L_W2[16 * 128 + gd];
#pragma unroll
            for (int tt = 0; tt < 16; ++tt) { const f32x4* g4 = (const f32x4*)(L_GG + (16 * seg + tt) * 16); float z = bias;
#pragma unroll
                for (int q4 = 0; q4 < 4; ++q4) { const f32x4 gv = g4[q4]; z += gv[0] * wcol[4 * q4] + gv[1] * wcol[4 * q4 + 1] + gv[2] * wcol[4 * q4 + 2] + gv[3] * wcol[4 * q4 + 3]; }
                const float ls = fminf(z, 0.f) - __logf(1.0f + __expf(-fabsf(z))); run += ls * (1.0f / 16.0f); bl[tt] = run; }
            L_SEG[seg * 128 + gd] = run;
            __syncthreads();
            { float off = 0.f;
#pragma unroll
              for (int s2 = 0; s2 < 3; ++s2) off += (s2 < seg) ? L_SEG[s2 * 128 + gd] : 0.f;
#pragma unroll
              for (int tt = 0; tt < 16; ++tt) L_B[(16 * seg + tt) * 128 + gd] = bl[tt] + off;
              if (seg == 3) *(float*)(ib + 49152 + gd * 4) = __expf(off + run); }
            __syncthreads();
#pragma unroll
            for (int i = 0; i < 2; ++i) { const int pc = tid + 512 * i, t = pc >> 4, c8 = (pc & 15) * 8;
                const f32x4 b0 = *(const f32x4*)(L_B + t * 128 + c8), b1 = *(const f32x4*)(L_B + t * 128 + c8 + 4), e0 = *(const f32x4*)(L_B + 63 * 128 + c8), e1 = *(const f32x4*)(L_B + 63 * 128 + c8 + 4);
                float qv[8], kv[8], bb[8], be[8];
#pragma unroll
                for (int e = 0; e < 4; ++e) { qv[2 * e] = bflo(qreg[i][e]); qv[2 * e + 1] = bfhi(qreg[i][e]); kv[2 * e] = bflo(kreg[i][e]); kv[2 * e + 1] = bfhi(kreg[i][e]); bb[e] = b0[e]; bb[4 + e] = b1[e]; be[e] = e0[e]; be[4 + e] = e1[e]; }
                float qt[8], kt[8], kh[8];
#pragma unroll
                for (int e = 0; e < 8; ++e) { const float en = __expf(-bb[e]); qt[e] = qv[e] * __expf(bb[e]); kt[e] = kv[e] * en; kh[e] = kt[e] * __expf(be[e]); }
                const int g16 = c8 >> 4, a = (c8 >> 3) & 1; const int colLo = (16 * g16 + 4 * a) * 2, colHi = colLo + 16; const int sw = (t & 7) << 4;
                const int aLo = t * 256 + ((colLo & ~15) ^ sw) + (colLo & 15), aHi = t * 256 + ((colHi & ~15) ^ sw) + (colHi & 15);
                u32x2 wq0, wq1, wk0, wk1; wq0.x = pk2(qt[0], qt[1]); wq0.y = pk2(qt[2], qt[3]); wq1.x = pk2(qt[4], qt[5]); wq1.y = pk2(qt[6], qt[7]);
                wk0.x = pk2(kt[0], kt[1]); wk0.y = pk2(kt[2], kt[3]); wk1.x = pk2(kt[4], kt[5]); wk1.y = pk2(kt[6], kt[7]);
                *(u32x2*)(ib + aLo) = wq0; *(u32x2*)(ib + aHi) = wq1; *(u32x2*)(ib + 16384 + aLo) = wk0; *(u32x2*)(ib + 16384 + aHi) = wk1;
                u32x4 wh; wh.x = pk2(kh[0], kh[1]); wh.y = pk2(kh[2], kh[3]); wh.z = pk2(kh[4], kh[5]); wh.w = pk2(kh[6], kh[7]);
                *(u32x4*)(ib + 32768 + att::v_st(t, c8)) = wh; }
            if (it + 1 < 8) G2_PREFETCH(c + 1);
        }
#undef G2_PREFETCH
    }
}
template <int OFF> DI s16x4 trr(int vb) { s16x4 r; asm volatile("ds_read_b64_tr_b16 %0, %1 offset:%2" : "=&v"(r) : "v"(vb), "i"(OFF) : "memory"); return r; }
#define GPK(L, H) (bf16x8){L[0], L[1], L[2], L[3], H[0], H[1], H[2], H[3]}
DI void scan(const Params& p, int j, unsigned char* lds) {
    const int tid = otid(), lane = tid & 63, w = tid >> 6, r = lane & 31, h = lane >> 5; unsigned char* ws = lws(p);
    const bf16_t* G = (const bf16_t*)(ws + WS_G); const unsigned char* img = ws + WS_GIMG;
    float* L_EEND = (float*)(lds + S_EEND);
    unsigned char* L_Q = lds + S_Q; unsigned char* L_K = lds + S_K; unsigned char* L_V = lds + S_V; unsigned char* L_P = lds + S_P;
    const int vbase = (int)(uintptr_t)L_V + (w >> 2) * 16384 + (w & 3) * 512 + att::v_rd_base(lane);
    const int kbase = (int)(uintptr_t)(lds + S_KH) + att::v_rd_base(lane);
    for (int unit = obid(); unit < 64; unit += ogrid()) {
        const int b = unit >> 3, hd = (unit >> 1) & 3, dir = unit & 1;
        bf16_t* ob = (bf16_t*)(ws + (dir ? WS_OBW : WS_OFW)) + (size_t)b * SEQ * 1024 + hd * 256;
        const bf16_t* Gv = G + (size_t)b * SEQ * 3072 + 1024 + hd * 256;
        f32x16 S[4];
#pragma unroll
        for (int kd = 0; kd < 4; ++kd)
#pragma unroll
            for (int i = 0; i < 16; ++i) S[kd][i] = 0.f;
        u32x4 ireg[6], vreg[4], ereg;
#define G2_LOAD(c) do { const unsigned char* ib = img + (size_t)(unit * 32 + (c)) * ITEM_BYTES; \
        _Pragma("unroll") for (int i = 0; i < 6; ++i) ireg[i] = *(const u32x4*)(ib + (tid + 512 * i) * 16); \
        if (tid < 32) ereg = *(const u32x4*)(ib + 49152 + tid * 16); \
        _Pragma("unroll") for (int i = 0; i < 4; ++i) { const int pc = tid + 512 * i, t = pc >> 5, c8 = (pc & 31) * 8; const int tok = dir ? (SEQ - 1 - (64 * (c) + t)) : (64 * (c) + t); \
            vreg[i] = *(const u32x4*)(Gv + ((unsigned)tok * 3072u + (unsigned)c8)); } } while (0)
        G2_LOAD(0);
        for (int c = 0; c < 32; ++c) {
            __syncthreads();
#pragma unroll
            for (int i = 0; i < 6; ++i) *(u32x4*)(lds + (tid + 512 * i) * 16) = ireg[i];
            if (tid < 32) *(u32x4*)(lds + S_EEND + tid * 16) = ereg;
#pragma unroll
            for (int i = 0; i < 4; ++i) { const int pc = tid + 512 * i, t = pc >> 5, c8 = (pc & 31) * 8; *(u32x4*)(L_V + (c8 >> 7) * 16384 + att::v_st(t, c8 & 127)) = vreg[i]; }
            if (c + 1 < 32) G2_LOAD(c + 1);
            __syncthreads();
            if (w < 3) { const int mt = (w + 1) >> 1, nt = w == 2 ? 1 : 0; f32x16 sc;
#pragma unroll
                for (int i = 0; i < 16; ++i) sc[i] = 0.f;
                const int rk = 32 * nt + r, rq = 32 * mt + r;
#pragma unroll
                for (int ks = 0; ks < 8; ++ks) { const int cb = 32 * ks + 16 * h;
                    const bf16x8 ka = *(const bf16x8*)(L_K + rk * 256 + (cb ^ ((rk & 7) << 4))); const bf16x8 qb = *(const bf16x8*)(L_Q + rq * 256 + (cb ^ ((rq & 7) << 4)));
                    sc = __builtin_amdgcn_mfma_f32_32x32x16_bf16(ka, qb, sc, 0, 0, 0); }
                if (w != 1) {
#pragma unroll
                    for (int i = 0; i < 16; ++i) { const int s = (i & 3) + 8 * (i >> 2) + 4 * h; const bool keep = dir ? (s < r) : (s <= r); sc[i] = keep ? sc[i] : 0.f; } }
#pragma unroll
                for (int g = 0; g < 4; ++g) { u32x2 wv; wv.x = pk2(sc[4 * g], sc[4 * g + 1]); wv.y = pk2(sc[4 * g + 2], sc[4 * g + 3]); *(u32x2*)(L_P + rq * 144 + (32 * nt + 8 * g + 4 * h) * 2) = wv; }
            } else if (w == 3) {
#pragma unroll
                for (int g = 0; g < 4; ++g) { u32x2 z2; z2.x = 0u; z2.y = 0u; *(u32x2*)(L_P + r * 144 + (32 + 8 * g + 4 * h) * 2) = z2; }
            }
            f32x16 oacc[2];
#pragma unroll
            for (int mt = 0; mt < 2; ++mt)
#pragma unroll
                for (int i = 0; i < 16; ++i) oacc[mt][i] = 0.f;
#pragma unroll
            for (int ks = 0; ks < 8; ++ks) { const bf16x8 sf = gla::packregs(S[ks >> 1], ks & 1); const int cb = 32 * ks + 16 * h;
#pragma unroll
                for (int mt = 0; mt < 2; ++mt) { const int rq = 32 * mt + r; const bf16x8 qa = *(const bf16x8*)(L_Q + rq * 256 + (cb ^ ((rq & 7) << 4)));
                    oacc[mt] = __builtin_amdgcn_mfma_f32_32x32x16_bf16(qa, sf, oacc[mt], 0, 0, 0); } }
            __syncthreads();
            bf16x8 vf[4];
            { const s16x4 l0 = trr<0>(vbase), h0 = trr<2048>(vbase), l1 = trr<4096>(vbase), h1 = trr<4096 + 2048>(vbase), l2 = trr<8192>(vbase), h2 = trr<8192 + 2048>(vbase), l3 = trr<12288>(vbase), h3 = trr<12288 + 2048>(vbase);
              asm volatile("s_waitcnt lgkmcnt(0)" ::: "memory"); __builtin_amdgcn_sched_barrier(0);
              vf[0] = GPK(l0, h0); vf[1] = GPK(l1, h1); vf[2] = GPK(l2, h2); vf[3] = GPK(l3, h3); }
#pragma unroll
            for (int mt = 0; mt < 2; ++mt)
#pragma unroll
                for (int ks = 0; ks < 4; ++ks) { const bf16x8 pa = *(const bf16x8*)(L_P + (32 * mt + r) * 144 + (16 * ks + 8 * h) * 2);
                    oacc[mt] = __builtin_amdgcn_mfma_f32_32x32x16_bf16(pa, vf[ks], oacc[mt], 0, 0, 0); }
#pragma unroll
            for (int mt = 0; mt < 2; ++mt)
#pragma unroll
                for (int i = 0; i < 16; ++i) { const int t = 32 * mt + (i & 3) + 8 * (i >> 2) + 4 * h; const int tok = dir ? (SEQ - 1 - (64 * c + t)) : (64 * c + t);
                    ob[(unsigned)tok * 1024u + (unsigned)(32 * w + r)] = (bf16_t)(pk2(oacc[mt][i], 0.f) & 0xffffu); }
#define G2_STATE(KD) do { \
            const s16x4 l0 = trr<(KD) * 512>(kbase), h0 = trr<(KD) * 512 + 2048>(kbase), l1 = trr<(KD) * 512 + 4096>(kbase), h1 = trr<(KD) * 512 + 4096 + 2048>(kbase), \
                        l2 = trr<(KD) * 512 + 8192>(kbase), h2 = trr<(KD) * 512 + 8192 + 2048>(kbase), l3 = trr<(KD) * 512 + 12288>(kbase), h3 = trr<(KD) * 512 + 12288 + 2048>(kbase); \
            asm volatile("s_waitcnt lgkmcnt(0)" ::: "memory"); __builtin_amdgcn_sched_barrier(0); \
            _Pragma("unroll") for (int g = 0; g < 4; ++g) { const f32x4 e4 = *(const f32x4*)(L_EEND + 32 * (KD) + 8 * g + 4 * h); \
                S[KD][4 * g] *= e4[0]; S[KD][4 * g + 1] *= e4[1]; S[KD][4 * g + 2] *= e4[2]; S[KD][4 * g + 3] *= e4[3]; } \
            S[KD] = __builtin_amdgcn_mfma_f32_32x32x16_bf16(GPK(l0, h0), vf[0], S[KD], 0, 0, 0); S[KD] = __builtin_amdgcn_mfma_f32_32x32x16_bf16(GPK(l1, h1), vf[1], S[KD], 0, 0, 0); \
            S[KD] = __builtin_amdgcn_mfma_f32_32x32x16_bf16(GPK(l2, h2), vf[2], S[KD], 0, 0, 0); S[KD] = __builtin_amdgcn_mfma_f32_32x32x16_bf16(GPK(l3, h3), vf[3], S[KD], 0, 0, 0); } while (0)
            G2_STATE(0); G2_STATE(1); G2_STATE(2); G2_STATE(3);
#undef G2_STATE
        }
        __syncthreads();
#undef G2_LOAD
    }
}
#undef GPK
}
DI void gla_gated_norm(const Params& p, int j) {
    const int tid = otid(), lane = tid & 63, l = lane & 31; unsigned char* ws = lws(p);
    const bf16_t* ofw = (const bf16_t*)(ws + WS_OFW); const bf16_t* obw = (const bf16_t*)(ws + WS_OBW); const bf16_t* G = (const bf16_t*)(ws + WS_G); bf16_t* on = (bf16_t*)(ws + WS_ON);
    const float* hn = IN(p, I_GLA_HN) + j * 256;
    const int wv = obid() * 8 + (tid >> 6), nwv = ogrid() * 8;
    float g8[8];
#pragma unroll
    for (int e = 0; e < 8; ++e) g8[e] = hn[l * 8 + e];
    for (int pr = wv; pr < MT * 2; pr += nwv) {
        const int rh = pr * 2 + (lane >> 5), row = rh >> 2, h = rh & 3; const size_t off = (size_t)row * 1024 + h * 256 + l * 8;
        const u32x4 a = *(const u32x4*)(ofw + off), bq = *(const u32x4*)(obw + off), rr = *(const u32x4*)(G + (size_t)row * 3072 + 2048 + h * 256 + l * 8);
        float o[8], rv[8];
#pragma unroll
        for (int e = 0; e < 4; ++e) { o[2 * e] = bflo(a[e]) + bflo(bq[e]); o[2 * e + 1] = bfhi(a[e]) + bfhi(bq[e]); rv[2 * e] = bflo(rr[e]); rv[2 * e + 1] = bfhi(rr[e]); }
        float ss = 0.f;
#pragma unroll
        for (int e = 0; e < 8; ++e) ss += o[e] * o[e];
#pragma unroll
        for (int s = 16; s >= 1; s >>= 1) ss += __shfl_xor(ss, s);
        const float rs = rsqrtf(ss * (1.0f / 256.0f) + EPS);
        float y[8];
#pragma unroll
        for (int e = 0; e < 8; ++e) y[e] = o[e] * rs * g8[e] * silu_f(rv[e]);
        u32x4 w; w.x = pk2(y[0], y[1]); w.y = pk2(y[2], y[3]); w.z = pk2(y[4], y[5]); w.w = pk2(y[6], y[7]);
        *(u32x4*)(on + off) = w;
    }
}
DI void final_norm(const Params& p) {
    const int tid = otid(), lane = tid & 63; unsigned char* ws = lws(p);
    const bf16_t* xb = (const bf16_t*)(ws + WS_XB); const float* ssq = (const float*)(ws + WS_SSQ) + (size_t)12 * MT * 16; const float* g = IN(p, I_FINAL_NORM);
    const int wv = obid() * 8 + (tid >> 6), nwv = ogrid() * 8;
    for (int row = wv; row < MT; row += nwv) { const float rs = row_rstd(ssq, row);
#pragma unroll
        for (int i = 0; i < 2; ++i) { const u32x4 xi = ((const u32x4*)(xb + (size_t)row * 1024))[lane + 64 * i];
            const f32x4 g0 = ((const f32x4*)g)[2 * (lane + 64 * i)], g1 = ((const f32x4*)g)[2 * (lane + 64 * i) + 1]; f32x4 o0, o1;
            o0[0] = bflo(xi[0]) * rs * g0[0]; o0[1] = bfhi(xi[0]) * rs * g0[1]; o0[2] = bflo(xi[1]) * rs * g0[2]; o0[3] = bfhi(xi[1]) * rs * g0[3];
            o1[0] = bflo(xi[2]) * rs * g1[0]; o1[1] = bfhi(xi[2]) * rs * g1[1]; o1[2] = bflo(xi[3]) * rs * g1[2]; o1[3] = bfhi(xi[3]) * rs * g1[3];
            float* op = lout(p) + (size_t)row * 1024 + 8 * (lane + 64 * i); *(f32x4*)op = o0; *(f32x4*)(op + 4) = o1; } }
}

constexpr int NPH = 38;
DI void run_phase(const Params& p, int ph, unsigned char* shm, float ascale) {
    unsigned char* ws = lws(p); LAS unsigned char* lds = (LAS unsigned char*)shm;
    bf16_t* xb = (bf16_t*)(ws + WS_XB); bf16_t* act = (bf16_t*)(ws + WS_ACT); float* ssq = (float*)(ws + WS_SSQ);
    if (ph == 0) { prep_phase(p); return; }
    if (ph == NPH - 1) { final_norm(p); return; }
    const int li = (ph - 1) / 9, sub = (ph - 1) % 9, j = li >> 1; const bool mla = li & 1;
    if (sub == 0 || sub == 7) { const int s = sub == 7; EpiGateUp E; E.act = act; E.rt = fill_rstd(shm, 5632, ssq + (size_t)(3 * li + (s ? 2 : 0)) * MT * 16, 0, 16, 1.0f / 1024.0f);
        run_gemm(lds, xb, (const bf16_t*)(ws + WS_WGU + (size_t)(li * 2 + s) * SZ_WGU), 5632, 1024, E); return; }
    if (sub == 1 || sub == 8) { const int s = sub == 8; EpiResid E; E.xb = xb; E.ssq_out = ssq + (size_t)(3 * li + (s ? 3 : 1)) * MT * 16; E.alpha = 0.5f * ascale;
        run_gemm(lds, act, (const bf16_t*)(ws + WS_WD + (size_t)(li * 2 + s) * SZ_WD), 1024, 2816, E); return; }
    const float* ssq_mix = ssq + (size_t)(3 * li + 1) * MT * 16;
    if (!mla) {
        if (sub == 2) { skinny_gemm<1, 0>(xb, (const bf16_t*)(ws + WS_GWG + (size_t)j * 32 * 1024 * 2), ssq_mix, (float*)(ws + WS_GG), nullptr, nullptr, nullptr, shm);
            __syncthreads();
            EpiGlaIn E; E.G = (bf16_t*)(ws + WS_G); E.rt = fill_rstd(shm, 3072, ssq_mix, 0, 16, 1.0f / 1024.0f); run_gemm(lds, xb, (const bf16_t*)(ws + WS_GWIN + (size_t)j * 3072 * 1024 * 2), 3072, 1024, E); return; }
        if (sub == 3) { gla2::prep(p, j, shm); return; }
        if (sub == 4) { gla2::scan(p, j, shm);
            if (ogrid() > 64 && obid() >= 64) cvt_weights(p, j == 0 ? CVT_S0 : CVT_S2, 64, ogrid() - 64);
            return; }
        if (sub == 5) { gla_gated_norm(p, j); return; }
        if (sub == 6) { EpiResid E; E.xb = xb; E.ssq_out = ssq + (size_t)(3 * li + 2) * MT * 16; E.alpha = 1.0f * ascale;
            run_gemm(lds, (const bf16_t*)(ws + WS_ON), (const bf16_t*)(ws + WS_GWOUT + (size_t)j * 1024 * 1024 * 2), 1024, 1024, E); return; }
    } else {
        float* ssq_qkv = (float*)(ws + WS_SSQQ) + (size_t)j * MT * 16;
        const float* ct = (const float*)(ws + WS_COS); const float* st = (const float*)(ws + WS_SIN);
        if (sub == 2) { skinny_gemm<2, 1>(xb, (const bf16_t*)(ws + WS_MWKPE + (size_t)j * 64 * 1024 * 2), ssq_mix, nullptr, (bf16_t*)(ws + WS_KB), ct, st, shm);
            __syncthreads();
            EpiMlaIn E; E.cq = (bf16_t*)(ws + WS_CQ); E.ckv = (bf16_t*)(ws + WS_CKV); E.rt = fill_rstd(shm, 1024, ssq_mix, 0, 16, 1.0f / 1024.0f); E.ssq_qkv = ssq_qkv;
            run_gemm(lds, xb, (const bf16_t*)(ws + WS_MWIN + (size_t)j * 1024 * 1024 * 2), 1024, 1024, E); return; }
        if (sub == 3) { { EpiUq E; E.Q = (bf16_t*)(ws + WS_Q); E.rt = fill_rstd(shm, 1536, ssq_qkv, 0, 12, 1.0f / 768.0f); E.ct = ct; E.st = st;
              run_gemm(lds, (const bf16_t*)(ws + WS_CQ), (const bf16_t*)(ws + WS_MWUQ + (size_t)j * 1536 * 768 * 2), 1536, 768, E); }
            __syncthreads();
            { const int un = (ogrid() == 256) ? 1 : 0;
              EpiUkv E; E.Kb = (bf16_t*)(ws + WS_KB); E.Vb = (bf16_t*)(ws + WS_VB); E.rt = fill_rstd(shm, 2048, ssq_qkv, 12, 4, 1.0f / 256.0f, un);
              run_gemm(lds, (const bf16_t*)(ws + WS_CKV), (const bf16_t*)(ws + WS_MWUKV + (size_t)j * 2048 * 256 * 2), 2048, 256, E, un); }
            return; }
        if (sub == 4) { const bf16_t* Q = (const bf16_t*)(ws + WS_Q); const bf16_t* Kb = (const bf16_t*)(ws + WS_KB); const bf16_t* Vb = (const bf16_t*)(ws + WS_VB); bf16_t* O = (bf16_t*)(ws + WS_O);
            for (int U = obid(); U < 512; U += ogrid()) { const int bh = (U & 7) + 8 * (U >> 6), qb = (U >> 3) & 7, b = bh >> 3, h = bh & 7;
                att::attn_body(Q + ((size_t)bh * SEQ + qb * 256) * 192, Kb + (size_t)bh * SEQ * 192, Vb + (size_t)bh * SEQ * 128, O + ((size_t)b * SEQ + qb * 256) * 1024 + h * 128, SEQ, (char*)shm); }
            return; }
        if (sub == 5) { EpiResid E; E.xb = xb; E.ssq_out = ssq + (size_t)(3 * li + 2) * MT * 16; E.alpha = 1.0f * ascale;
            run_gemm(lds, (const bf16_t*)(ws + WS_O), (const bf16_t*)(ws + WS_MWOUT + (size_t)j * 1024 * 1024 * 2), 1024, 1024, E); return; }
    }
}
DI bool phase_empty(int ph) { if (ph == 0 || ph == NPH - 1) return false; const int li = (ph - 1) / 9, sub = (ph - 1) % 9; return (li & 1) && sub == 6; }
__global__ void __launch_bounds__(512, 2) mega_fwd(Params p) {
    extern __shared__ __attribute__((aligned(16))) unsigned char shm[];
    cg::grid_group grid = cg::this_grid();
    volatile LAS unsigned* xst = (volatile LAS unsigned*)((LAS unsigned char*)shm + LDS_XB_OFF);
    if (threadIdx.x < 4) xst[threadIdx.x] = 0u;
    __syncthreads();
    const XcdBarrier xb = xcd_barrier_post((unsigned*)(p.ws + WS_BAR), xst);
#ifndef PROBE_MASK
#define PROBE_MASK 0ull
#endif
#ifndef PROBE_REPS
#define PROBE_REPS 1
#endif
#ifdef PROBE_SYNCS
    for (int i = 0; i < PROBE_SYNCS; ++i) xcd_barrier(xb);
#endif
    grid.sync();
    for (int ph = p.ph_lo; ph < p.ph_hi; ++ph) {
        if (phase_empty(ph)) continue;
        const int reps = ((PROBE_MASK >> ph) & 1ull) ? 1 + PROBE_REPS : 1;
        for (int rep = 0; rep < reps; ++rep) {
            run_phase(p, ph, shm, rep ? 0.f : 1.f);
            if (ph + 1 < p.ph_hi || rep + 1 < reps) xcd_barrier(xb);
        }
    }
}

extern "C" void kernel_launch(void* const* d_in, const int* in_sizes, int n_in, void* d_out, int out_size, void* d_ws, size_t ws_size, hipStream_t stream) {
    static int grid = 0;
    if (grid == 0) {
        if (n_in != 18 || out_size != MT * DM || ws_size < WS_END) { fprintf(stderr, "kernel_launch: unexpected shapes (n_in %d out %d ws %zu need %zu)\n", n_in, out_size, ws_size, (size_t)WS_END); grid = -1; return; }
        int dev = 0, cus = 0, per_cu = 0;
        if (hipGetDevice(&dev) != hipSuccess || hipDeviceGetAttribute(&cus, hipDeviceAttributeMultiprocessorCount, dev) != hipSuccess) { grid = -1; return; }
        if (hipFuncSetAttribute((const void*)mega_fwd, hipFuncAttributeMaxDynamicSharedMemorySize, LDS_BYTES) != hipSuccess) { fprintf(stderr, "kernel_launch: hipFuncSetAttribute failed\n"); grid = -1; return; }
        if (hipOccupancyMaxActiveBlocksPerMultiprocessor(&per_cu, (const void*)mega_fwd, 512, LDS_BYTES) != hipSuccess || per_cu < 1) { fprintf(stderr, "kernel_launch: occupancy query says %d\n", per_cu); per_cu = 1; }
        (void)hipGetLastError();
        grid = cus;
    }
    if (grid < 0) return;
    if (hipMemsetAsync((char*)d_ws + WS_BAR, 0, WS_BAR_BYTES, stream) != hipSuccess) { fprintf(stderr, "kernel_launch: memset of the barrier words failed\n"); return; }
    Params p{};
    for (int i = 0; i < 18; ++i) p.in[i] = (const float*)d_in[i];
    p.out = (float*)d_out; p.ws = (unsigned char*)d_ws;
    for (int i = 0; i < 32; ++i) p.inv_freq[i] = 1.0f / powf(10000.0f, (float)(2 * i) / 64.0f);
#ifndef MK_PER_PHASE
#define MK_PER_PHASE 0
#endif
    const int nl = MK_PER_PHASE ? NPH : 1;
    for (int li = 0; li < nl; ++li) {
        p.ph_lo = MK_PER_PHASE ? li : 0; p.ph_hi = MK_PER_PHASE ? li + 1 : NPH;
        void* args[] = {&p};
        hipError_t e = hipLaunchCooperativeKernel((const void*)mega_fwd, dim3(grid), dim3(512), args, LDS_BYTES, stream);
        if (e != hipSuccess) { fprintf(stderr, "kernel_launch: cooperative launch failed: %s (grid %d)\n", hipGetErrorString(e), grid); break; }
    }
}
```
